# Optimizing an MI355X kernel written in HIP

```python
import jax, jax.numpy as jnp
from jax import lax
import numpy as np

D_MODEL = 1024
BATCH = 4
SEQ = 8192
DEPTH = 1

M_HEADS = 4
M_DH = D_MODEL // 8
M_W = M_HEADS * M_DH
M_CHUNK = 64
CONV_K = 4
F_HEADS = 8
F_DH = D_MODEL // 16
F_W = F_HEADS * F_DH
Q_BLOCK = 128
D_MIX = M_W + F_W
EPS = 1e-6

SPLITS = (M_W, M_W, M_W, M_W, M_W, M_HEADS, M_HEADS,
          F_W, F_W, F_W, F_W, F_HEADS)
SPLIT_IDX = [int(s) for s in np.cumsum(SPLITS)[:-1]]
D_IN = int(sum(SPLITS))

kernel_name = "hymba_mlstm_fox_adaln_layer"


def rms_norm(x, g):
    xf = x.astype(jnp.float32)
    y = xf * lax.rsqrt(jnp.mean(xf * xf, axis=-1, keepdims=True) + EPS)
    return (y * g.astype(jnp.float32)).astype(x.dtype)


def head_layer_norm(x, g):
    xf = x.astype(jnp.float32)
    mu = jnp.mean(xf, axis=-1, keepdims=True)
    var = jnp.mean((xf - mu) ** 2, axis=-1, keepdims=True)
    y = (xf - mu) * lax.rsqrt(var + EPS)
    y = y.reshape(x.shape[:-2] + (x.shape[-2] * x.shape[-1],))
    return (y * g.astype(jnp.float32)).astype(x.dtype)


def causal_depthwise_conv(x, w, b):
    rhs = w.reshape(CONV_K, 1, x.shape[-1])
    y = lax.conv_general_dilated(x, rhs.astype(x.dtype), window_strides=(1,),
                                 padding=[(CONV_K - 1, 0)],
                                 dimension_numbers=('NWC', 'WIO', 'NWC'),
                                 feature_group_count=x.shape[-1])
    return y + b


def mlstm_chunkwise(q, k, v, ig, lf):
    B, H, S, d = q.shape
    L = M_CHUNK
    NC = S // L

    def to_chunks(a):
        return jnp.moveaxis(a.reshape(a.shape[:2] + (NC, L) + a.shape[3:]), 2, 0)

    qc, kc, vc = to_chunks(q), to_chunks(k), to_chunks(v)
    ic = to_chunks(ig)
    bc = jnp.cumsum(to_chunks(lf), axis=-1)
    causal = jnp.tril(jnp.ones((L, L), dtype=bool))

    def step(carry, inp):
        C, n, m = carry
        qj, kj, vj, ij, bj = inp
        D = bj[..., :, None] - bj[..., None, :] + ij[..., None, :]
        D = jnp.where(causal, D, -jnp.inf)
        inter = bj + m[..., None]
        m_t = jnp.maximum(inter, jnp.max(D, axis=-1))
        w_inter = jnp.exp(inter - m_t)
        s = jnp.einsum('bhtd,bhsd->bhts', qj, kj) * jnp.exp(D - m_t[..., None])
        num = (w_inter[..., None] * jnp.einsum('bhtd,bhde->bhte', qj, C)
               + jnp.einsum('bhts,bhse->bhte', s, vj))
        den = w_inter * jnp.einsum('bhtd,bhd->bht', qj, n) + jnp.sum(s, axis=-1)
        h = num / jnp.maximum(jnp.abs(den), jnp.exp(-m_t))[..., None]
        bL = bj[..., -1]
        a = bL[..., None] - bj + ij
        m_new = jnp.maximum(bL + m, jnp.max(a, axis=-1))
        decay = jnp.exp(bL + m - m_new)
        ws = jnp.exp(a - m_new[..., None])
        C_new = decay[..., None, None] * C + jnp.einsum('bhs,bhsd,bhse->bhde', ws, kj, vj)
        n_new = decay[..., None] * n + jnp.einsum('bhs,bhsd->bhd', ws, kj)
        return (C_new, n_new, m_new), h

    init = (jnp.zeros((B, H, d, d), jnp.float32), jnp.zeros((B, H, d), jnp.float32),
            jnp.zeros((B, H), jnp.float32))
    _, hs = lax.scan(step, init, (qc, kc, vc, ic, bc))
    return hs.transpose(1, 0, 3, 2, 4).reshape(B, S, H, d)


def forgetting_attention(q, k, v, logf):
    B, H, S, d = q.shape
    NB = S // Q_BLOCK
    F = jnp.cumsum(logf, axis=-1)
    qb = q.reshape(B, H, NB, Q_BLOCK, d).transpose(2, 0, 1, 3, 4)
    Fb = F.reshape(B, H, NB, Q_BLOCK).transpose(2, 0, 1, 3)
    kpos = jnp.arange(S)
    scale = 1.0 / np.sqrt(d)

    def block(args):
        qi, Fi, i = args
        qpos = i * Q_BLOCK + jnp.arange(Q_BLOCK)
        logits = (jnp.einsum('bhqd,bhkd->bhqk', qi, k).astype(jnp.float32) * scale
                  + Fi[..., :, None] - F[..., None, :])
        logits = jnp.where(kpos[None, :] <= qpos[:, None], logits, -jnp.inf)
        p = jax.nn.softmax(logits, axis=-1)
        return jnp.einsum('bhqk,bhkd->bhqd', p.astype(v.dtype), v)

    out = lax.map(block, (qb, Fb, jnp.arange(NB)))
    return out.transpose(1, 0, 3, 2, 4).reshape(B, S, H, d)


def setup_inputs(seed: int = 0) -> dict:
    key = jax.random.key(seed)
    ks = jax.random.split(key, 16)
    f32 = jnp.float32
    x = jax.random.normal(ks[0], (BATCH, SEQ, D_MODEL), f32)
    c = jax.random.normal(ks[1], (BATCH, D_MODEL), f32)
    norm_g = 1.0 + 0.02 * jax.random.normal(ks[2], (DEPTH, D_MODEL), f32)
    w_ada = 0.5 * D_MODEL ** -0.5 * jax.random.normal(ks[3], (DEPTH, D_MODEL, 3 * D_MODEL), f32)
    b_ada = 0.02 * jax.random.normal(ks[4], (DEPTH, 3 * D_MODEL), f32)
    w_in = D_MODEL ** -0.5 * jax.random.normal(ks[5], (DEPTH, D_MODEL, D_IN), f32)
    conv_w = CONV_K ** -0.5 * jax.random.normal(ks[6], (DEPTH, CONV_K, 2 * M_W), f32)
    conv_b = 0.01 * jax.random.normal(ks[7], (DEPTH, 2 * M_W), f32)
    b_igate = 0.1 * jax.random.normal(ks[8], (DEPTH, M_HEADS), f32)
    b_fgate_m = (jnp.linspace(3.0, 6.0, M_HEADS, dtype=f32)[None, :]
                 + 0.1 * jax.random.normal(ks[9], (DEPTH, M_HEADS), f32))
    mlstm_norm_g = 1.0 + 0.02 * jax.random.normal(ks[10], (DEPTH, M_W), f32)
    b_fgate_f = (jnp.linspace(1.0, 5.0, F_HEADS, dtype=f32)[None, :]
                 + 0.1 * jax.random.normal(ks[11], (DEPTH, F_HEADS), f32))
    fox_qnorm_g = 1.0 + 0.02 * jax.random.normal(ks[12], (DEPTH, F_DH), f32)
    fox_knorm_g = 1.0 + 0.02 * jax.random.normal(ks[13], (DEPTH, F_DH), f32)
    w_out = D_MIX ** -0.5 * jax.random.normal(ks[14], (DEPTH, D_MIX, D_MODEL), f32)
    return {"x": x, "c": c, "norm_g": norm_g, "w_ada": w_ada, "b_ada": b_ada,
            "w_in": w_in, "conv_w": conv_w, "conv_b": conv_b, "b_igate": b_igate,
            "b_fgate_m": b_fgate_m, "mlstm_norm_g": mlstm_norm_g, "b_fgate_f": b_fgate_f,
            "fox_qnorm_g": fox_qnorm_g, "fox_knorm_g": fox_knorm_g, "w_out": w_out}


def reference(x, c, norm_g, w_ada, b_ada, w_in, conv_w, conv_b, b_igate, b_fgate_m,
              mlstm_norm_g, b_fgate_f, fox_qnorm_g, fox_knorm_g, w_out):
    B, S, _ = x.shape
    f32 = jnp.float32
    for l in range(DEPTH):
        mod = c @ w_ada[l] + b_ada[l]
        shift, scale, gate = jnp.split(mod, 3, axis=-1)
        h = rms_norm(x, norm_g[l]) * (1.0 + scale[:, None, :]) + shift[:, None, :]

        u = h @ w_in[l]
        (m_q, m_k, m_v, m_o, m_z, m_i, m_f,
         f_q, f_k, f_v, f_z, f_f) = jnp.split(u, SPLIT_IDX, axis=-1)

        qk = jax.nn.silu(causal_depthwise_conv(jnp.concatenate([m_q, m_k], axis=-1),
                                               conv_w[l], conv_b[l]))
        mq, mk = jnp.split(qk, 2, axis=-1)
        to_bhsd = lambda a, H, d: a.reshape(B, S, H, d).transpose(0, 2, 1, 3).astype(f32)
        mq = to_bhsd(mq, M_HEADS, M_DH)
        mk = to_bhsd(mk, M_HEADS, M_DH) * (1.0 / np.sqrt(M_DH))
        mv = to_bhsd(m_v, M_HEADS, M_DH)
        ig = (m_i.astype(f32) + b_igate[l].astype(f32)).transpose(0, 2, 1)
        lf = jax.nn.log_sigmoid(m_f.astype(f32) + b_fgate_m[l].astype(f32)).transpose(0, 2, 1)
        h_m = mlstm_chunkwise(mq, mk, mv, ig, lf)
        h_m = jax.nn.sigmoid(m_o.astype(f32)).reshape(B, S, M_HEADS, M_DH) * h_m
        y_m = head_layer_norm(h_m, mlstm_norm_g[l]).astype(x.dtype) * jax.nn.silu(m_z)

        fq = rms_norm(f_q.reshape(B, S, F_HEADS, F_DH), fox_qnorm_g[l]).transpose(0, 2, 1, 3)
        fk = rms_norm(f_k.reshape(B, S, F_HEADS, F_DH), fox_knorm_g[l]).transpose(0, 2, 1, 3)
        fv = f_v.reshape(B, S, F_HEADS, F_DH).transpose(0, 2, 1, 3)
        logf = jax.nn.log_sigmoid(f_f.astype(f32) + b_fgate_f[l].astype(f32)).transpose(0, 2, 1)
        h_f = forgetting_attention(fq, fk, fv, logf)
        y_f = h_f.reshape(B, S, F_W).astype(x.dtype) * jax.nn.silu(f_z)

        y = jnp.concatenate([y_m, y_f], axis=-1) @ w_out[l]
        x = x + gate[:, None, :] * y
    return x
```

```cpp
#include <hip/hip_runtime.h>
#include <hip/hip_cooperative_groups.h>
#include <cstdio>
#include <cstdint>
#include <cmath>
namespace cg = cooperative_groups;

#define LAS __attribute__((address_space(3)))
typedef unsigned short bf16_t;
typedef short bf16x8 __attribute__((ext_vector_type(8)));
typedef short s16x4 __attribute__((ext_vector_type(4)));
typedef float f32x4 __attribute__((ext_vector_type(4)));
typedef float f32x16 __attribute__((ext_vector_type(16)));
typedef unsigned u32x4 __attribute__((ext_vector_type(4)));
typedef unsigned u32x2 __attribute__((ext_vector_type(2)));

constexpr int T_ = 32768, SEQ = 8192, DM = 1024, DIN = 4624, NU = 4608;
constexpr int UC_MV = 1024, UC_MO = 1536, UC_MZ = 2048, UC_FQ = 2560, UC_FK = 3072, UC_FV = 3584, UC_FZ = 4096;
constexpr float C2 = 0.125f * 1.4426950408889634f;
constexpr float LOG2E = 1.4426950408889634f;
constexpr float EPS = 1e-6f;
constexpr int CE = 144;
constexpr int CST_ELEMS = CE * 128;

constexpr size_t MiB = 1u << 20;
constexpr size_t WS_MOD = 1 * MiB;
constexpr size_t WS_WG = 1 * MiB + 65536;
constexpr size_t WS_WTIN = 2 * MiB;
constexpr size_t WS_WTOUT = 12 * MiB;
constexpr size_t WS_GATES = 14 * MiB;
constexpr size_t WS_H = 16 * MiB;
constexpr size_t WS_FF = 80 * MiB;
constexpr size_t WS_MG = 81 * MiB;
constexpr size_t WS_MGR = 81 * MiB + 512 * 1024;
constexpr size_t WS_MFL = 82 * MiB;
constexpr size_t WS_U = 84 * MiB;
constexpr size_t WS_CST = 372 * MiB;
constexpr size_t WS_Y = 444 * MiB;
constexpr size_t WS_QC = 16 * MiB, WS_KC = 48 * MiB;
constexpr size_t WS_END = 508 * MiB;

constexpr int LDS_BYTES = 135168;

struct Params {
    const float *x, *c, *norm_g, *w_ada, *b_ada, *w_in, *conv_w, *conv_b, *b_ig, *b_fm, *mnorm_g, *b_ff, *gq, *gk, *w_out;
    float* out; unsigned char* ws;
};

__device__ __forceinline__ unsigned cvt_pk_bf16(float lo, float hi) { unsigned r; asm volatile("v_cvt_pk_bf16_f32 %0, %1, %2" : "=v"(r) : "v"(lo), "v"(hi)); return r; }
typedef float f32x2_t __attribute__((ext_vector_type(2))); typedef __bf16 bf16x2_t __attribute__((ext_vector_type(2)));
__device__ __forceinline__ unsigned cvt_pk_bf16_c(float lo, float hi) { f32x2_t v = {lo, hi}; bf16x2_t b = __builtin_convertvector(v, bf16x2_t); return __builtin_bit_cast(unsigned, b); }
__device__ __forceinline__ float bflo(unsigned w) { return __uint_as_float(w << 16); }
__device__ __forceinline__ float bfhi(unsigned w) { return __uint_as_float(w & 0xffff0000u); }
__device__ __forceinline__ float wave_sum(float v) {
#pragma unroll
    for (int o = 1; o < 64; o <<= 1) v += __shfl_xor(v, o);
    return v;
}
__device__ __forceinline__ float sigmoid_f(float x) { return __builtin_amdgcn_rcpf(1.f + __expf(-x)); }
__device__ __forceinline__ float silu_f(float x) { return x * __builtin_amdgcn_rcpf(1.f + __expf(-x)); }
__device__ __forceinline__ float logsigmoid_f(float z) { const float e = __expf(-fabsf(z)); return fminf(z, 0.f) - __logf(1.0f + e); }
#define LDS_BARRIER() asm volatile("s_waitcnt lgkmcnt(0)\n\ts_barrier" ::: "memory")
typedef short v4i16_t __attribute__((ext_vector_type(4)));
__device__ __forceinline__ s16x4 tr16(const LAS unsigned char* p) { return __builtin_bit_cast(s16x4, __builtin_amdgcn_ds_read_tr16_b64_v4i16((LAS v4i16_t*)p)); }
__device__ __forceinline__ bf16x8 cat8(s16x4 a, s16x4 b) { return (bf16x8){a[0], a[1], a[2], a[3], b[0], b[1], b[2], b[3]}; }

namespace pg8 {
#define PG8_LAS __attribute__((address_space(3)))
constexpr int BM = 256, BK = 64, HALF = 128, HTB = HALF * BK * 2, NXCD = 8, WGM = 8;
__host__ __device__ __forceinline__ int lds_byte(int r, int c) { const int st = (r >> 4) * 2 + (c >> 5), rr = r & 15, cc = c & 31, ob = rr * 64 + cc * 2; return st * 1024 + (ob ^ (((ob >> 9) & 1) << 5)); }
__host__ __device__ __forceinline__ void stage_rc(int b, int& R, int& C) { const int st = b / 1024, sb = b % 1024, swz = sb ^ (((sb >> 9) & 1) << 5); R = (st >> 1) * 16 + swz / 64; C = (st & 1) * 32 + (swz % 64) / 2; }
__host__ __device__ __forceinline__ int perm32(int rho) { const int n = rho >> 4, i = rho & 15; return 8 * (i >> 2) + 4 * n + (i & 3); }
struct Unit { int pm, pn; };
struct Gemm { const bf16_t* A; const bf16_t* Bt; int M, N, K; };
struct StaticOrder {
    int nM, nN, nwg, G, c;
    __host__ __device__ void init(int M, int N, int G_, int c_) { nM = M / BM; nN = N / BM; nwg = nM * nN; G = G_; c = c_; }
    __host__ __device__ bool next(int i, Unit& u) const {
        const long L = (long)i * G + c; if (L >= nwg) return false;
        int wgid = (int)L; { const int q = nwg / NXCD, r = nwg % NXCD, xcd = wgid % NXCD, off = wgid / NXCD; wgid = (xcd < r ? xcd * (q + 1) : r * (q + 1) + (xcd - r) * q) + off; }
        const int nig = WGM * nN, gid = wgid / nig, fm = gid * WGM, gsz = (nM - fm) < WGM ? (nM - fm) : WGM;
        u.pm = fm + ((wgid % nig) % gsz); u.pn = (wgid % nig) / gsz; return true;
    }
    __device__ __forceinline__ void a_ready(const Unit&) const {}
    __device__ __forceinline__ void done(const Unit&) const {}
};
struct EpiU {
    static constexpr bool PERM = true, AFTER_DRAIN = false;
    bf16_t* O; int ldc;
    __device__ __forceinline__ void operator()(const f32x4 (&acc)[2][2][4][2], const Unit& u, int wr, int wc, int fr, int fq) const {
        const int row0 = u.pm * BM + wr * 64 + fr; const int col0 = u.pn * BM + wc * 32 + 8 * fq;
        asm volatile("s_nop 15\n\ts_nop 7" ::: "memory");
#pragma unroll
        for (int ai = 0; ai < 2; ++ai)
#pragma unroll
            for (int m = 0; m < 4; ++m) { bf16_t* rowp = O + (size_t)(row0 + ai * HALF + m * 16) * ldc + col0;
#pragma unroll
                for (int bj = 0; bj < 2; ++bj) { const f32x4 v0 = acc[ai][bj][m][0], v1 = acc[ai][bj][m][1];
                    u32x4 w; w.x = cvt_pk_bf16(v0[0], v0[1]); w.y = cvt_pk_bf16(v0[2], v0[3]); w.z = cvt_pk_bf16(v1[0], v1[1]); w.w = cvt_pk_bf16(v1[2], v1[3]);
                    *(u32x4*)(rowp + bj * HALF) = w; } }
    }
};
struct EpiOut {
    static constexpr bool PERM = true, AFTER_DRAIN = false;
    const float* x; const float* mod; float* out;
    __device__ __forceinline__ void operator()(const f32x4 (&acc)[2][2][4][2], const Unit& u, int wr, int wc, int fr, int fq) const {
        const int row0 = u.pm * BM + wr * 64 + fr; const int col0 = u.pn * BM + wc * 32 + 8 * fq;
        const int b = (u.pm * BM) >> 13;
        f32x4 gv[2][2];
#pragma unroll
        for (int bj = 0; bj < 2; ++bj)
#pragma unroll
            for (int n = 0; n < 2; ++n) gv[bj][n] = *(const f32x4*)(mod + b * 3072 + 2048 + col0 + bj * HALF + 4 * n);
#pragma unroll
        for (int ai = 0; ai < 2; ++ai)
#pragma unroll
            for (int mp = 0; mp < 2; ++mp) {
                f32x4 xv[2][2][2];
#pragma unroll
                for (int mm = 0; mm < 2; ++mm) { const size_t ro = (size_t)(row0 + ai * HALF + (2 * mp + mm) * 16) * DM + col0;
#pragma unroll
                    for (int bj = 0; bj < 2; ++bj)
#pragma unroll
                        for (int n = 0; n < 2; ++n) xv[mm][bj][n] = *(const f32x4*)(x + ro + bj * HALF + 4 * n); }
                __builtin_amdgcn_sched_barrier(0);
#pragma unroll
                for (int mm = 0; mm < 2; ++mm) { const size_t ro = (size_t)(row0 + ai * HALF + (2 * mp + mm) * 16) * DM + col0;
#pragma unroll
                    for (int bj = 0; bj < 2; ++bj)
#pragma unroll
                        for (int n = 0; n < 2; ++n) *(f32x4*)(out + ro + bj * HALF + 4 * n) = xv[mm][bj][n] + gv[bj][n] * acc[ai][bj][2 * mp + mm][n]; }
            }
    }
};

template <class Epi, class Sched, bool ALIGN_EPI = false>
__device__ __forceinline__ void gemm_phase(PG8_LAS unsigned char* lds, const Gemm g, const Sched& S, const Epi& E) {
    const int tid = threadIdx.x, wid = __builtin_amdgcn_readfirstlane(tid >> 6), lane = tid & 63, wr = wid >> 2, wc = wid & 3, fr = lane & 15, fq = lane >> 4;
    const int K = g.K, nt = K / BK;
    unsigned voffA[2], voffB[2];
#pragma unroll
    for (int i = 0; i < 2; ++i) { int R, C; stage_rc(tid * 16 + i * 8192, R, C); const int Rb = Epi::PERM ? ((R & ~31) + perm32(R & 31)) : R;
        voffA[i] = (unsigned)(R * K + C) * 2u; voffB[i] = (unsigned)(Rb * K + C) * 2u; }
    const size_t kstep = (size_t)(BK * 2);
    const size_t hstep = (size_t)HALF * K * 2;
    const size_t tstep = 2 * hstep;
    const unsigned ldsw = (unsigned)wid * 1024u;
    const int aoff = lds_byte(wr * 64 + fr, fq * 8), boff = lds_byte(wc * 32 + fr, fq * 8);
#define PG8_SA(b, h) (((b) * 2 + (h)) * HTB)
#define PG8_SB(b, h) ((4 + (b) * 2 + (h)) * HTB)
#define PG8_STAGE(bufoff, gbase, voff) do { _Pragma("unroll") for (int _i = 0; _i < 2; ++_i) \
        __builtin_amdgcn_global_load_lds((const unsigned*)((const char*)(gbase) + (voff)[_i]), (PG8_LAS unsigned*)(lds + (bufoff) + ldsw + _i * 8192), 16, 0, 0); } while (0)
#define PG8_LDA(dst, b, h) do { _Pragma("unroll") for (int m = 0; m < 4; ++m) _Pragma("unroll") for (int k = 0; k < 2; ++k) dst[m][k] = *(const PG8_LAS bf16x8*)(lds + PG8_SA(b, h) + aoff + m * 2048 + k * 1024); } while (0)
#define PG8_LDB(dst, b, h) do { _Pragma("unroll") for (int n = 0; n < 2; ++n) _Pragma("unroll") for (int k = 0; k < 2; ++k) dst[n][k] = *(const PG8_LAS bf16x8*)(lds + PG8_SB(b, h) + boff + n * 2048 + k * 1024); } while (0)
#define PG8_MMA(ai, bj, At, Bt) do { __builtin_amdgcn_s_setprio(1); _Pragma("unroll") for (int m = 0; m < 4; ++m) _Pragma("unroll") for (int n = 0; n < 2; ++n) _Pragma("unroll") for (int k = 0; k < 2; ++k) \
        acc[ai][bj][m][n] = __builtin_amdgcn_mfma_f32_16x16x32_bf16(Bt[n][k], At[m][k], acc[ai][bj][m][n], 0, 0, 0); __builtin_amdgcn_s_setprio(0); } while (0)
#define PG8_WAIT_V(n) asm volatile("s_waitcnt vmcnt(" #n ")" ::: "memory")
#define PG8_WAIT_L(n) asm volatile("s_waitcnt lgkmcnt(" #n ")" ::: "memory")
#define PG8_BAR __builtin_amdgcn_s_barrier()
#define PG8_SCHED __builtin_amdgcn_sched_barrier(0)
    Unit cur, nxt; int ui = 0;
    if (!S.next(0, cur)) return;
    f32x4 acc[2][2][4][2];
#pragma unroll
    for (int a = 0; a < 2; ++a)
#pragma unroll
        for (int b = 0; b < 2; ++b)
#pragma unroll
            for (int m = 0; m < 4; ++m)
#pragma unroll
                for (int n = 0; n < 2; ++n) acc[a][b][m][n] = (f32x4){0.f, 0.f, 0.f, 0.f};
    bf16x8 At[4][2], B0[2][2], B1[2][2];
    const char* cA = (const char*)g.A + (size_t)cur.pm * tstep; const char* cB = (const char*)g.Bt + (size_t)cur.pn * tstep;
    S.a_ready(cur);
    PG8_STAGE(PG8_SB(0, 0), cB, voffB); PG8_STAGE(PG8_SB(0, 1), cB + hstep, voffB); PG8_STAGE(PG8_SA(0, 0), cA, voffA); PG8_STAGE(PG8_SA(0, 1), cA + hstep, voffA);
    if (wr == 1) PG8_BAR;
    PG8_WAIT_V(2); PG8_BAR;
    PG8_STAGE(PG8_SB(1, 0), cB + kstep, voffB); PG8_STAGE(PG8_SA(1, 0), cA + kstep, voffA); PG8_STAGE(PG8_SB(1, 1), cB + hstep + kstep, voffB);
    PG8_WAIT_V(6); PG8_BAR;
    for (;;) {
        const bool has_next = S.next(ui + 1, nxt);
        const char* nA = has_next ? (const char*)g.A + (size_t)nxt.pm * tstep : cA; const char* nB = has_next ? (const char*)g.Bt + (size_t)nxt.pn * tstep : cB;
        for (int t = 0; t < nt; t += 2) {
            const bool last = (t == nt - 2);
            const char* a1 = cA + (size_t)(t + 1) * kstep;
            const char* a2 = last ? nA : cA + (size_t)(t + 2) * kstep; const char* b2 = last ? nB : cB + (size_t)(t + 2) * kstep;
            const char* a3 = a2 + kstep; const char* b3 = b2 + kstep;
            if (last && has_next) S.a_ready(nxt);
            PG8_LDB(B0, 0, 0); PG8_LDB(B1, 0, 1); PG8_SCHED; PG8_LDA(At, 0, 0); PG8_STAGE(PG8_SA(1, 1), a1 + hstep, voffA);
            PG8_WAIT_V(8); PG8_WAIT_L(0); PG8_BAR; PG8_MMA(0, 0, At, B0); PG8_MMA(0, 1, At, B1); PG8_BAR; PG8_SCHED;
            PG8_LDA(At, 0, 1); PG8_STAGE(PG8_SB(0, 0), b2, voffB); PG8_STAGE(PG8_SB(0, 1), b2 + hstep, voffB); PG8_STAGE(PG8_SA(0, 0), a2, voffA);
            PG8_WAIT_V(8); PG8_WAIT_L(0); PG8_BAR; PG8_MMA(1, 0, At, B0); PG8_MMA(1, 1, At, B1); PG8_BAR; PG8_SCHED;
            PG8_LDB(B0, 1, 0); PG8_LDB(B1, 1, 1); PG8_SCHED; PG8_LDA(At, 1, 0); PG8_STAGE(PG8_SA(0, 1), a2 + hstep, voffA);
            PG8_WAIT_V(8); PG8_WAIT_L(0); PG8_BAR; PG8_MMA(0, 0, At, B0); PG8_MMA(0, 1, At, B1); PG8_BAR; PG8_SCHED;
            PG8_LDA(At, 1, 1); PG8_STAGE(PG8_SB(1, 0), b3, voffB); PG8_STAGE(PG8_SB(1, 1), b3 + hstep, voffB); PG8_STAGE(PG8_SA(1, 0), a3, voffA);
            PG8_WAIT_V(8); PG8_WAIT_L(0); PG8_BAR; PG8_MMA(1, 0, At, B0); PG8_MMA(1, 1, At, B1); PG8_BAR; PG8_SCHED;
        }
        if constexpr (ALIGN_EPI) { if (wr == 0) PG8_BAR; }
        E(acc, cur, wr, wc, fr, fq); S.done(cur);
        if (!has_next) break;
#pragma unroll
        for (int a = 0; a < 2; ++a)
#pragma unroll
            for (int b = 0; b < 2; ++b)
#pragma unroll
                for (int m = 0; m < 4; ++m)
#pragma unroll
                    for (int n = 0; n < 2; ++n) acc[a][b][m][n] = (f32x4){0.f, 0.f, 0.f, 0.f};
        cur = nxt; cA = nA; cB = nB; ++ui;
        if constexpr (ALIGN_EPI) { if (wr == 1) PG8_BAR; }
    }
    PG8_WAIT_V(0);
    if constexpr (!ALIGN_EPI) { if (wr == 0) PG8_BAR; }
    PG8_BAR;
#undef PG8_SA
#undef PG8_SB
#undef PG8_STAGE
#undef PG8_LDA
#undef PG8_LDB
#undef PG8_MMA
#undef PG8_WAIT_V
#undef PG8_WAIT_L
#undef PG8_BAR
#undef PG8_SCHED
}
}

__device__ __forceinline__ void p0_transpose_item(const float* W, int Nsrc, int K, bf16_t* WT, int src0, int dst0, int k0, LAS float* scr, int lane) {
#pragma unroll 8
    for (int i = 0; i < 32; ++i) { const int kk = 2 * i + (lane >> 5); scr[kk * 33 + (lane & 31)] = W[(size_t)(k0 + kk) * Nsrc + src0 + (lane & 31)]; }
    asm volatile("s_waitcnt lgkmcnt(0)" ::: "memory");
    const int c = lane & 7;
#pragma unroll
    for (int j = 0; j < 4; ++j) { const int n = (lane >> 3) + 8 * j; const LAS float* s = scr + (8 * c) * 33 + n;
        u32x4 o; o.x = cvt_pk_bf16(s[0 * 33], s[1 * 33]); o.y = cvt_pk_bf16(s[2 * 33], s[3 * 33]); o.z = cvt_pk_bf16(s[4 * 33], s[5 * 33]); o.w = cvt_pk_bf16(s[6 * 33], s[7 * 33]);
        *(u32x4*)(WT + (size_t)(dst0 + n) * K + k0 + 8 * c) = o; }
    asm volatile("s_waitcnt lgkmcnt(0)" ::: "memory");
}

__device__ __forceinline__ void p0_weights(const Params& p, LAS unsigned char* lds) {
    const int tid = threadIdx.x, lane = tid & 63, wave = tid >> 6;
    unsigned char* ws = p.ws;
    {
        LAS float* scr = (LAS float*)(lds + wave * 8704);
        bf16_t* WTin = (bf16_t*)(ws + WS_WTIN); bf16_t* WTout = (bf16_t*)(ws + WS_WTOUT);
        const int gw = blockIdx.x * 8 + wave, NGW = gridDim.x * 8;
        constexpr int I_A = 16 * 80, I_B = 16 * 64, I_O = 16 * 32;
        for (int it = gw; it < I_A + I_B + I_O; it += NGW) {
            int r = it;
            if (r < I_A) { const int kb = r / 80, nb = r % 80; p0_transpose_item(p.w_in, DIN, DM, WTin, nb * 32, nb * 32, kb * 64, scr, lane); continue; } r -= I_A;
            if (r < I_B) { const int kb = r / 64, nb = r % 64; p0_transpose_item(p.w_in, DIN, DM, WTin, 2568 + nb * 32, 2560 + nb * 32, kb * 64, scr, lane); continue; } r -= I_B;
            { const int kb = r / 32, nb = r % 32; p0_transpose_item(p.w_out, DM, DM, WTout, nb * 32, nb * 32, kb * 64, scr, lane); }
        }
    }
}
__device__ __forceinline__ void phase0(const Params& p, LAS unsigned char* lds) {
    const int tid = threadIdx.x, lane = tid & 63, wave = tid >> 6;
    unsigned char* ws = p.ws;
    {
        float* wg = (float*)(ws + WS_WG);
        for (int i = blockIdx.x * 512 + tid; i < 16 * 1024; i += gridDim.x * 512) { const int j = i >> 10, k = i & 1023; const int col = (j < 8) ? 2560 + j : 4616 + (j - 8); wg[i] = p.w_in[(size_t)k * DIN + col]; }
    }
    __syncthreads();
    {
        float* mod = (float*)(ws + WS_MOD);
        LAS float* red = (LAS float*)lds;
        for (int cb = blockIdx.x; cb < 192; cb += gridDim.x) {
            const int cl = tid & 15, kp = tid >> 4, col = cb * 16 + cl;
            float a0 = 0.f, a1 = 0.f, a2 = 0.f, a3 = 0.f;
#pragma unroll 16
            for (int k = kp * 32; k < kp * 32 + 32; ++k) { const float w = p.w_ada[(size_t)k * 3072 + col];
                a0 += p.c[k] * w; a1 += p.c[1024 + k] * w; a2 += p.c[2048 + k] * w; a3 += p.c[3072 + k] * w; }
            red[(kp * 16 + cl) * 4 + 0] = a0; red[(kp * 16 + cl) * 4 + 1] = a1; red[(kp * 16 + cl) * 4 + 2] = a2; red[(kp * 16 + cl) * 4 + 3] = a3;
            __syncthreads();
            if (tid < 64) { const int c2 = tid & 15, b = tid >> 4; float s = 0.f;
                for (int k2 = 0; k2 < 32; ++k2) s += red[(k2 * 16 + c2) * 4 + b];
                mod[b * 3072 + cb * 16 + c2] = s + p.b_ada[cb * 16 + c2]; }
            __syncthreads();
        }
    }
}

__device__ __forceinline__ void phase1a(const Params& p, LAS unsigned char* lds) {
    const int tid = threadIdx.x, lane = tid & 63, wave = tid >> 6;
    unsigned char* ws = p.ws;
    const float* mod = (const float*)(ws + WS_MOD);
    const float* wgG = (const float*)(ws + WS_WG);
    p0_weights(p, lds);
    __syncthreads();
    LAS float* wg = (LAS float*)lds;
    for (int i = tid; i < 16 * 1024 / 4; i += 512) ((LAS f32x4*)wg)[i] = ((const f32x4*)wgG)[i];
    __syncthreads();
    bf16_t* H = (bf16_t*)(ws + WS_H); float* G = (float*)(ws + WS_GATES);
    const int NGW = gridDim.x * 8;
    for (int grp = blockIdx.x * 8 + wave; grp < T_ / 16; grp += NGW) {
        const int mb = grp * 16, b = mb >> 13;
        f32x4 A4[4], S4[4];
#pragma unroll
        for (int j = 0; j < 4; ++j) { const int c = 4 * (lane + 64 * j);
            const f32x4 g4 = *(const f32x4*)(p.norm_g + c), sh = *(const f32x4*)(mod + b * 3072 + c), sc = *(const f32x4*)(mod + b * 3072 + 1024 + c);
            A4[j] = g4 * (sc + 1.0f); S4[j] = sh; }
        f32x4 v[4], n[4];
        { const f32x4* x0 = (const f32x4*)(p.x + (size_t)mb * DM) + lane;
#pragma unroll
          for (int j = 0; j < 4; ++j) n[j] = x0[64 * j]; }
#pragma unroll 1
        for (int r = 0; r < 16; ++r) {
            const int m = mb + r;
#pragma unroll
            for (int j = 0; j < 4; ++j) v[j] = n[j];
            { const f32x4* xn = (const f32x4*)(p.x + (size_t)((r + 1 < 16) ? m + 1 : m) * DM) + lane;
#pragma unroll
                for (int j = 0; j < 4; ++j) n[j] = xn[64 * j]; }
            float ss = 0.f;
#pragma unroll
            for (int j = 0; j < 4; ++j) ss += (v[j].x * v[j].x + v[j].y * v[j].y) + (v[j].z * v[j].z + v[j].w * v[j].w);
            const float rstd = __builtin_amdgcn_rsqf(wave_sum(ss) * (1.f / DM) + EPS);
            float ga[16];
#pragma unroll
            for (int q = 0; q < 16; ++q) ga[q] = 0.f;
            unsigned long long* o8 = (unsigned long long*)(H + (size_t)m * DM) + lane;
#pragma unroll
            for (int j = 0; j < 4; ++j) {
                const int c = 4 * (lane + 64 * j);
                const f32x4 h4 = (v[j] * rstd) * A4[j] + S4[j];
                o8[64 * j] = (unsigned long long)cvt_pk_bf16(h4.x, h4.y) | ((unsigned long long)cvt_pk_bf16(h4.z, h4.w) << 32);
#pragma unroll
                for (int q = 0; q < 16; ++q) { const f32x4 w4 = *(const LAS f32x4*)(wg + q * 1024 + c); ga[q] += (h4.x * w4.x + h4.y * w4.y) + (h4.z * w4.z + h4.w * w4.w); }
            }
            float r8[8], r4[4], r2[2], r1;
            { const bool up = (lane & 32) != 0;
#pragma unroll
              for (int i = 0; i < 8; ++i) { const float keep = up ? ga[i + 8] : ga[i], send = up ? ga[i] : ga[i + 8]; r8[i] = keep + __shfl_xor(send, 32); } }
            { const bool up = (lane & 16) != 0;
#pragma unroll
              for (int i = 0; i < 4; ++i) { const float keep = up ? r8[i + 4] : r8[i], send = up ? r8[i] : r8[i + 4]; r4[i] = keep + __shfl_xor(send, 16); } }
            { const bool up = (lane & 8) != 0;
#pragma unroll
              for (int i = 0; i < 2; ++i) { const float keep = up ? r4[i + 2] : r4[i], send = up ? r4[i] : r4[i + 2]; r2[i] = keep + __shfl_xor(send, 8); } }
            { const bool up = (lane & 4) != 0; const float keep = up ? r2[1] : r2[0], send = up ? r2[0] : r2[1]; r1 = keep + __shfl_xor(send, 4); }
            r1 += __shfl_xor(r1, 2); r1 += __shfl_xor(r1, 1);
            if ((lane & 3) == 0) { const int idx = ((lane >> 5) & 1) * 8 + ((lane >> 4) & 1) * 4 + ((lane >> 3) & 1) * 2 + ((lane >> 2) & 1); G[(size_t)m * 16 + idx] = r1; }
        }
    }
}

__device__ __forceinline__ u32x4 conv8(const Params& p, const bf16_t* U, size_t m, int t, int c0, float mul) {
    float acc[8];
    { const f32x4 b0 = *(const f32x4*)(p.conv_b + c0), b1 = *(const f32x4*)(p.conv_b + c0 + 4);
      acc[0] = b0[0]; acc[1] = b0[1]; acc[2] = b0[2]; acc[3] = b0[3]; acc[4] = b1[0]; acc[5] = b1[1]; acc[6] = b1[2]; acc[7] = b1[3]; }
#pragma unroll
    for (int j = 0; j < 4; ++j) {
        if (t - 3 + j >= 0) {
            const u32x4 w = *(const u32x4*)(U + (m - 3 + j) * NU + c0);
            const f32x4 w0 = *(const f32x4*)(p.conv_w + j * 1024 + c0), w1 = *(const f32x4*)(p.conv_w + j * 1024 + c0 + 4);
            acc[0] += w0[0] * bflo(w.x); acc[1] += w0[1] * bfhi(w.x); acc[2] += w0[2] * bflo(w.y); acc[3] += w0[3] * bfhi(w.y);
            acc[4] += w1[0] * bflo(w.z); acc[5] += w1[1] * bfhi(w.z); acc[6] += w1[2] * bflo(w.w); acc[7] += w1[3] * bfhi(w.w);
        }
    }
#pragma unroll
    for (int i = 0; i < 8; ++i) acc[i] = silu_f(acc[i]) * mul;
    u32x4 o; o.x = cvt_pk_bf16(acc[0], acc[1]); o.y = cvt_pk_bf16(acc[2], acc[3]); o.z = cvt_pk_bf16(acc[4], acc[5]); o.w = cvt_pk_bf16(acc[6], acc[7]);
    return o;
}
constexpr float KSCALE = 0.08838834764831845f;

__device__ __forceinline__ float block_excl_scan_add(float v, LAS float* scr, int tid, float& total) {
    const int lane = tid & 63, wave = tid >> 6;
    float inc = v;
#pragma unroll
    for (int o = 1; o < 64; o <<= 1) { const float t = __shfl_up(inc, o); if (lane >= o) inc += t; }
    if (lane == 63) scr[wave] = inc;
    __syncthreads();
    float base = 0.f, tot = 0.f;
#pragma unroll
    for (int w = 0; w < 8; ++w) { const float s = scr[w]; if (w < wave) base += s; tot += s; }
    __syncthreads();
    total = tot;
    return base + inc - v;
}
__device__ __forceinline__ float block_excl_scan_max(float v, LAS float* scr, int tid) {
    const int lane = tid & 63, wave = tid >> 6;
    float inc = v;
#pragma unroll
    for (int o = 1; o < 64; o <<= 1) { const float t = __shfl_up(inc, o); if (lane >= o) inc = fmaxf(inc, t); }
    if (lane == 63) scr[wave] = inc;
    __syncthreads();
    float base = -INFINITY;
#pragma unroll
    for (int w = 0; w < 8; ++w) { const float s = scr[w]; if (w < wave) base = fmaxf(base, s); }
    __syncthreads();
    float ex = __shfl_up(inc, 1); if (lane == 0) ex = -INFINITY;
    return fmaxf(base, ex);
}

__device__ __forceinline__ void phase2a(const Params& p, LAS unsigned char* lds) {
    const int tid = threadIdx.x;
    unsigned char* ws = p.ws;
    const float* G = (const float*)(ws + WS_GATES);
    bf16_t* U = (bf16_t*)(ws + WS_U);
    LAS float* scr = (LAS float*)lds;
    for (int s = blockIdx.x; s < 48; s += gridDim.x) {
        const int t0 = tid * 16;
        if (s < 32) {
            const int b = s >> 3, h = s & 7; const float bias = p.b_ff[h];
            float lf[16]; float run = 0.f;
#pragma unroll
            for (int i = 0; i < 16; ++i) { run += logsigmoid_f(G[((size_t)b * SEQ + t0 + i) * 16 + 8 + h] + bias); lf[i] = run; }
            float tot; const float off = block_excl_scan_add(run, scr, tid, tot);
            float* F = (float*)(ws + WS_FF) + (size_t)s * SEQ + t0;
#pragma unroll
            for (int i = 0; i < 16; ++i) F[i] = off + lf[i];
        } else {
            const int bh = s - 32, b = bh >> 2, h = bh & 3; const float bf = p.b_fm[h], bi = p.b_ig[h];
            float Fc[16], ig[16]; float run = 0.f;
#pragma unroll
            for (int i = 0; i < 16; ++i) { const float* gr = G + ((size_t)b * SEQ + t0 + i) * 16; run += logsigmoid_f(gr[4 + h] + bf); Fc[i] = run; ig[i] = gr[h] + bi; }
            float tot; const float off = block_excl_scan_add(run, scr, tid, tot);
            float gg[16]; float mx = -INFINITY;
#pragma unroll
            for (int i = 0; i < 16; ++i) { Fc[i] += off; gg[i] = ig[i] - Fc[i]; mx = fmaxf(mx, gg[i]); }
            float gr_run = fmaxf(0.f, block_excl_scan_max(mx, scr, tid));
            float* MG = (float*)(ws + WS_MG) + (size_t)bh * SEQ + t0; float* MGR = (float*)(ws + WS_MGR) + (size_t)bh * SEQ + t0; float* MFL = (float*)(ws + WS_MFL) + (size_t)bh * SEQ + t0;
#pragma unroll
            for (int i = 0; i < 16; ++i) { gr_run = fmaxf(gr_run, gg[i]); MG[i] = gg[i]; MGR[i] = gr_run; MFL[i] = __expf(-Fc[i] - gr_run); }
        }
    }
    if (blockIdx.x >= 48 || gridDim.x <= 48) {
        bf16_t* QC = (bf16_t*)(ws + WS_QC); bf16_t* KC = (bf16_t*)(ws + WS_KC);
        const int nb = (gridDim.x > 48) ? (int)gridDim.x - 48 : (int)gridDim.x, b0 = (gridDim.x > 48) ? (int)blockIdx.x - 48 : (int)blockIdx.x;
        const int ch = tid & 127, c0 = ch * 8;
        const float mul = (ch < 64) ? 1.0f : KSCALE;
        float wt[4][8], bs[8];
#pragma unroll
        for (int i = 0; i < 8; ++i) { bs[i] = p.conv_b[c0 + i];
#pragma unroll
            for (int jt = 0; jt < 4; ++jt) wt[jt][i] = p.conv_w[jt * 1024 + c0 + i]; }
        bf16_t* dstb = (ch < 64) ? (QC + c0) : (KC + (c0 - 512));
#pragma unroll 1
        for (int run = b0 * 4 + (tid >> 7); run < T_ / 8; run += nb * 4) {
            const size_t mb = (size_t)run * 8; const int tb = (int)(mb & (SEQ - 1));
            u32x4 r[11];
#pragma unroll
            for (int i = 0; i < 11; ++i) { if (tb - 3 + i >= 0) r[i] = *(const u32x4*)(U + (mb - 3 + i) * NU + c0); else r[i] = (u32x4){0u, 0u, 0u, 0u}; }
#pragma unroll
            for (int o = 0; o < 8; ++o) {
                float acc[8];
#pragma unroll
                for (int i = 0; i < 8; ++i) acc[i] = bs[i];
#pragma unroll
                for (int jt = 0; jt < 4; ++jt) { const u32x4 w = r[o + jt];
                    acc[0] += wt[jt][0] * bflo(w.x); acc[1] += wt[jt][1] * bfhi(w.x); acc[2] += wt[jt][2] * bflo(w.y); acc[3] += wt[jt][3] * bfhi(w.y);
                    acc[4] += wt[jt][4] * bflo(w.z); acc[5] += wt[jt][5] * bfhi(w.z); acc[6] += wt[jt][6] * bflo(w.w); acc[7] += wt[jt][7] * bfhi(w.w); }
#pragma unroll
                for (int i = 0; i < 8; ++i) acc[i] = silu_f(acc[i]) * mul;
                u32x4 ov; ov.x = cvt_pk_bf16(acc[0], acc[1]); ov.y = cvt_pk_bf16(acc[2], acc[3]); ov.z = cvt_pk_bf16(acc[4], acc[5]); ov.w = cvt_pk_bf16(acc[6], acc[7]);
                *(u32x4*)(dstb + (mb + o) * 512) = ov;
            }
        }
        {
            const size_t NIT = (size_t)T_ * 64;
            const float* gkp = p.gk + (tid & 7) * 8;
            const f32x4 g0 = *(const f32x4*)gkp, g1 = *(const f32x4*)(gkp + 4);
            bf16_t* Uw = (bf16_t*)(ws + WS_U);
#pragma unroll 1
            for (size_t it = (size_t)b0 * 512 + tid; it < NIT; it += (size_t)nb * 512 * 4) {
                u32x4 w[4];
#pragma unroll
                for (int u = 0; u < 4; ++u) { const size_t i2 = it + (size_t)u * nb * 512; const size_t i3 = (i2 < NIT) ? i2 : it; w[u] = *(const u32x4*)(Uw + (i3 >> 6) * NU + UC_FK + (int)(i3 & 63) * 8); }
#pragma unroll
                for (int u = 0; u < 4; ++u) {
                    const size_t i2 = it + (size_t)u * nb * 512;
                    float ss = (bflo(w[u].x) * bflo(w[u].x) + bfhi(w[u].x) * bfhi(w[u].x)) + (bflo(w[u].y) * bflo(w[u].y) + bfhi(w[u].y) * bfhi(w[u].y))
                             + (bflo(w[u].z) * bflo(w[u].z) + bfhi(w[u].z) * bfhi(w[u].z)) + (bflo(w[u].w) * bflo(w[u].w) + bfhi(w[u].w) * bfhi(w[u].w));
                    ss += __shfl_xor(ss, 1); ss += __shfl_xor(ss, 2); ss += __shfl_xor(ss, 4);
                    const float r = __builtin_amdgcn_rsqf(ss * (1.f / 64.f) + EPS);
                    u32x4 o; o.x = cvt_pk_bf16(bflo(w[u].x) * r * g0[0], bfhi(w[u].x) * r * g0[1]); o.y = cvt_pk_bf16(bflo(w[u].y) * r * g0[2], bfhi(w[u].y) * r * g0[3]);
                    o.z = cvt_pk_bf16(bflo(w[u].z) * r * g1[0], bfhi(w[u].z) * r * g1[1]); o.w = cvt_pk_bf16(bflo(w[u].w) * r * g1[2], bfhi(w[u].w) * r * g1[3]);
                    if (i2 < NIT) *(u32x4*)(Uw + (i2 >> 6) * NU + UC_FK + (int)(i2 & 63) * 8) = o;
                }
            }
        }
    }
}

constexpr int PQ = 272, PV = 304, PP = 144;
constexpr int L_Q = 0, L_K = 17408, L_V = 34816, L_C = 54272, L_P = 93440;

__device__ __forceinline__ void mlstm_a_phase(const Params& p, LAS unsigned char* lds, int first, int stride) {
    const int tid = threadIdx.x, lane = tid & 63, wid = tid >> 6;
    unsigned char* ws = p.ws;
    const bf16_t* KC = (const bf16_t*)(ws + WS_KC);
    const bf16_t* U = (const bf16_t*)(ws + WS_U);
    const int row0 = tid >> 4, ch = tid & 15;
    u32x4 rk[2], rv[2]; float rg[2], rge = 0.f;
#define A_LOAD(unit_) do { const int bh_ = (unit_) >> 7, j_ = (unit_) & 127, b_ = bh_ >> 2, h_ = bh_ & 3; const size_t m0_ = (size_t)b_ * SEQ + j_ * 64; \
        const float* MG_ = (const float*)(ws + WS_MG) + (size_t)bh_ * SEQ + j_ * 64; \
        rge = ((const float*)(ws + WS_MGR))[(size_t)bh_ * SEQ + j_ * 64 + 63]; \
        _Pragma("unroll") for (int i = 0; i < 2; ++i) { const int row = row0 + 32 * i; rg[i] = MG_[row]; \
            rk[i] = *(const u32x4*)(KC + (m0_ + row) * 512 + h_ * 128 + ch * 8); rv[i] = *(const u32x4*)(U + (m0_ + row) * NU + UC_MV + h_ * 128 + ch * 8); } } while (0)
    int unit = first;
    if (unit >= 2048) return;
    A_LOAD(unit);
    if (tid < 128) { const int row = tid >> 1, c2 = 16 + (tid & 1); u32x4 o = {0u, 0u, 0u, 0u}; if (c2 == 16) o.x = 0x3F80u; *(LAS u32x4*)(lds + L_V + row * PV + c2 * 16) = o; }
#pragma unroll 1
    for (; unit < 2048; unit += stride) {
#pragma unroll
        for (int i = 0; i < 2; ++i) { const int row = row0 + 32 * i; const float sc = __expf(rg[i] - rge); const u32x4 w = rk[i];
            u32x4 o; o.x = cvt_pk_bf16(bflo(w.x) * sc, bfhi(w.x) * sc); o.y = cvt_pk_bf16(bflo(w.y) * sc, bfhi(w.y) * sc); o.z = cvt_pk_bf16(bflo(w.z) * sc, bfhi(w.z) * sc); o.w = cvt_pk_bf16(bflo(w.w) * sc, bfhi(w.w) * sc);
            *(LAS u32x4*)(lds + L_K + row * PQ + ch * 16) = o;
            *(LAS u32x4*)(lds + L_V + row * PV + ch * 16) = rv[i]; }
        LDS_BARRIER();
        if (unit + stride < 2048) A_LOAD(unit + stride);
        {
            const int g = lane >> 4, q = (lane & 15) >> 2, pp = lane & 3, fr = lane & 15;
            const int d0 = 16 * wid;
            bf16x8 af[2];
#pragma unroll
            for (int kk = 0; kk < 2; ++kk) {
                const LAS unsigned char* a0 = lds + L_K + (32 * kk + 8 * g + q) * PQ + (d0 + 4 * pp) * 2;
                af[kk] = cat8(tr16(a0), tr16(a0 + 4 * PQ));
            }
            bf16_t* dst = (bf16_t*)(ws + WS_CST) + (size_t)unit * CST_ELEMS;
#pragma unroll
            for (int et = 0; et < 9; ++et) {
                f32x4 acc = {0.f, 0.f, 0.f, 0.f};
#pragma unroll
                for (int kk = 0; kk < 2; ++kk) {
                    const LAS unsigned char* b0 = lds + L_V + (32 * kk + 8 * g + q) * PV + (16 * et + 4 * pp) * 2;
                    const bf16x8 bfv = cat8(tr16(b0), tr16(b0 + 4 * PV));
                    acc = __builtin_amdgcn_mfma_f32_16x16x32_bf16(af[kk], bfv, acc, 0, 0, 0);
                }
                u32x2 o; o.x = cvt_pk_bf16_c(acc[0], acc[1]); o.y = cvt_pk_bf16_c(acc[2], acc[3]);
                *(LAS u32x2*)(lds + L_C + (16 * et + fr) * PQ + (d0 + 4 * g) * 2) = o;
            }
            LDS_BARRIER();
#pragma unroll
            for (int i = 0; i < 5; ++i) { const int item = tid + 512 * i; if (item < CE * 16) *(u32x4*)(dst + (item >> 4) * 128 + (item & 15) * 8) = *(const LAS u32x4*)(lds + L_C + (item >> 4) * PQ + (item & 15) * 16); }
        }
        LDS_BARRIER();
    }
#undef A_LOAD
}

constexpr int SCAN_ITEMS = 16 * (CST_ELEMS / 2) / 512;
__device__ __forceinline__ void mlstm_scan(const Params& p, int blk) {
    unsigned char* ws = p.ws;
    const int gid = blk * 512 + threadIdx.x;
    const int bh = gid / (CST_ELEMS / 2), el = (gid % (CST_ELEMS / 2)) * 2;
    bf16_t* base = (bf16_t*)(ws + WS_CST) + (size_t)bh * 128 * CST_ELEMS + el;
    const float* MGR = (const float*)(ws + WS_MGR) + (size_t)bh * SEQ;
    float c0 = 0.f, c1 = 0.f; float gprev = 0.f;
#pragma unroll 1
    for (int j0 = 0; j0 < 128; j0 += 32) {
        unsigned d[32]; float ge[32];
#pragma unroll
        for (int i = 0; i < 32; ++i) { d[i] = *(const unsigned*)(base + (size_t)(j0 + i) * CST_ELEMS); ge[i] = MGR[(j0 + i) * 64 + 63]; }
#pragma unroll
        for (int i = 0; i < 32; ++i) {
            *(unsigned*)(base + (size_t)(j0 + i) * CST_ELEMS) = cvt_pk_bf16(c0, c1);
            const float dec = __expf(gprev - ge[i]); gprev = ge[i];
            c0 = dec * c0 + bflo(d[i]); c1 = dec * c1 + bfhi(d[i]);
        }
    }
}

__device__ __forceinline__ void mlstm_c_phase(const Params& p, LAS unsigned char* lds, int first, unsigned* qctr, LAS int* qslot, int cbase) {
    const int tid = threadIdx.x, lane = tid & 63, wid = tid >> 6;
    unsigned char* ws = p.ws;
    const bf16_t* U = (const bf16_t*)(ws + WS_U);
    const bf16_t* QC = (const bf16_t*)(ws + WS_QC); const bf16_t* KC = (const bf16_t*)(ws + WS_KC);
    const int row0 = tid >> 4, ch = tid & 15;
    const int fr = lane & 15, fq = lane >> 4;
    u32x4 rq[2], rk[2], rv[2], rc[5];
#define C_LOAD(unit_) do { const int bh_ = (unit_) >> 7, j_ = (unit_) & 127, b_ = bh_ >> 2, h_ = bh_ & 3; const size_t m0_ = (size_t)b_ * SEQ + j_ * 64; \
        const bf16_t* CS_ = (const bf16_t*)(ws + WS_CST) + (size_t)(unit_) * CST_ELEMS; \
        _Pragma("unroll") for (int i = 0; i < 2; ++i) { const int row = row0 + 32 * i; \
            rq[i] = *(const u32x4*)(QC + (m0_ + row) * 512 + h_ * 128 + ch * 8); rk[i] = *(const u32x4*)(KC + (m0_ + row) * 512 + h_ * 128 + ch * 8); \
            rv[i] = *(const u32x4*)(U + (m0_ + row) * NU + UC_MV + h_ * 128 + ch * 8); } \
        _Pragma("unroll") for (int i = 0; i < 5; ++i) { const int item = tid + 512 * i; if (item < CE * 16) rc[i] = *(const u32x4*)(CS_ + (item >> 4) * 128 + (item & 15) * 8); } } while (0)
    int unit = first;
    if (unit >= 2048) return;
    C_LOAD(unit);
    if (tid < 128) { const int row = tid >> 1, c2 = 16 + (tid & 1); u32x4 o = {0u, 0u, 0u, 0u}; if (c2 == 16) o.x = 0x3F80u; *(LAS u32x4*)(lds + L_V + row * PV + c2 * 16) = o; }
#pragma unroll 1
    for (; unit < 2048; ) {
        const int bh = unit >> 7, j = unit & 127, b = bh >> 2, h = bh & 3;
        const size_t m0 = (size_t)b * SEQ + j * 64;
        const float* MG = (const float*)(ws + WS_MG) + (size_t)bh * SEQ + j * 64;
        const float* MGR = (const float*)(ws + WS_MGR) + (size_t)bh * SEQ + j * 64;
        const float* MFL = (const float*)(ws + WS_MFL) + (size_t)bh * SEQ + j * 64;
#pragma unroll
        for (int i = 0; i < 2; ++i) { const int row = row0 + 32 * i;
            *(LAS u32x4*)(lds + L_Q + row * PQ + ch * 16) = rq[i]; *(LAS u32x4*)(lds + L_K + row * PQ + ch * 16) = rk[i]; *(LAS u32x4*)(lds + L_V + row * PV + ch * 16) = rv[i]; }
#pragma unroll
        for (int i = 0; i < 5; ++i) { const int item = tid + 512 * i; if (item < CE * 16) *(LAS u32x4*)(lds + L_C + (item >> 4) * PQ + (item & 15) * 16) = rc[i]; }
        if (tid == 0) *qslot = (int)__hip_atomic_fetch_add(qctr, 1u, __ATOMIC_RELAXED, __HIP_MEMORY_SCOPE_AGENT);
        LDS_BARRIER();
        const int nxt = *qslot - cbase;
        const int t0a = 16 * (wid & 3);
        const float Gt = MGR[t0a + fr];
        const f32x4 g4a = *(const f32x4*)(MG + 16 * ((wid >> 2) * 2) + 4 * fq), g4b = *(const f32x4*)(MG + 16 * ((wid >> 2) * 2 + 1) + 4 * fq);
        const float Gprev_raw = MGR[(j == 0) ? 0 : -1];
        const float flr = MFL[t0a + fr];
        const size_t m = m0 + t0a + fr;
        u32x2 ow[8], zw[8];
        if (wid < 4) {
#pragma unroll
            for (int et = 0; et < 8; ++et) { const int e = 16 * et + 4 * fq; ow[et] = *(const u32x2*)(U + m * NU + UC_MO + h * 128 + e); zw[et] = *(const u32x2*)(U + m * NU + UC_MZ + h * 128 + e); }
        }
        __builtin_amdgcn_sched_barrier(0);
        { const int nl = (nxt < 2048) ? nxt : 2047; C_LOAD(nl); }
        __builtin_amdgcn_sched_barrier(0);
        {
            const int t0 = t0a;
#pragma unroll
            for (int si = 0; si < 2; ++si) {
                const int s0 = 16 * ((wid >> 2) * 2 + si);
                f32x4 acc = {0.f, 0.f, 0.f, 0.f};
#pragma unroll
                for (int kk = 0; kk < 4; ++kk) {
                    const bf16x8 ka = *(const LAS bf16x8*)(lds + L_K + (s0 + fr) * PQ + (32 * kk + 8 * fq) * 2);
                    const bf16x8 qb = *(const LAS bf16x8*)(lds + L_Q + (t0 + fr) * PQ + (32 * kk + 8 * fq) * 2);
                    acc = __builtin_amdgcn_mfma_f32_16x16x32_bf16(ka, qb, acc, 0, 0, 0);
                }
                const f32x4 g4 = si ? g4b : g4a;
                float pv[4];
#pragma unroll
                for (int jj = 0; jj < 4; ++jj) { const int s_ = s0 + 4 * fq + jj; pv[jj] = (s_ <= t0 + fr) ? acc[jj] * __expf(g4[jj] - Gt) : 0.f; }
                u32x2 o; o.x = cvt_pk_bf16(pv[0], pv[1]); o.y = cvt_pk_bf16(pv[2], pv[3]);
                *(LAS u32x2*)(lds + L_P + (t0 + fr) * PP + (s0 + 4 * fq) * 2) = o;
            }
        }
        LDS_BARRIER();
        if (wid < 4) {
            const int t0 = 16 * wid;
            const int g = fq, q = (lane & 15) >> 2, pp = lane & 3;
            f32x4 acc[9];
#pragma unroll
            for (int et = 0; et < 9; ++et) acc[et] = (f32x4){0.f, 0.f, 0.f, 0.f};
#pragma unroll
            for (int kk = 0; kk < 4; ++kk) {
                const bf16x8 qb = *(const LAS bf16x8*)(lds + L_Q + (t0 + fr) * PQ + (32 * kk + 8 * fq) * 2);
#pragma unroll
                for (int et = 0; et < 9; ++et) {
                    const bf16x8 ca = *(const LAS bf16x8*)(lds + L_C + (16 * et + fr) * PQ + (32 * kk + 8 * fq) * 2);
                    acc[et] = __builtin_amdgcn_mfma_f32_16x16x32_bf16(ca, qb, acc[et], 0, 0, 0);
                }
            }
            const float Gprev = (j == 0) ? 0.f : Gprev_raw;
            const float wi = __expf(Gprev - Gt);
#pragma unroll
            for (int et = 0; et < 9; ++et) acc[et] = acc[et] * wi;
#pragma unroll
            for (int kk = 0; kk < 2; ++kk) {
                const bf16x8 pb = *(const LAS bf16x8*)(lds + L_P + (t0 + fr) * PP + (32 * kk + 8 * fq) * 2);
#pragma unroll
                for (int et = 0; et < 9; ++et) {
                    const LAS unsigned char* a0 = lds + L_V + (32 * kk + 8 * g + q) * PV + (16 * et + 4 * pp) * 2;
                    const bf16x8 va = cat8(tr16(a0), tr16(a0 + 4 * PV));
                    acc[et] = __builtin_amdgcn_mfma_f32_16x16x32_bf16(va, pb, acc[et], 0, 0, 0);
                }
            }
            const float den = __shfl(acc[8][0], fr);
            const float inv = __builtin_amdgcn_rcpf(fmaxf(fabsf(den), flr));
            float hm[8][4]; float s1 = 0.f;
#pragma unroll
            for (int et = 0; et < 8; ++et) {
                hm[et][0] = sigmoid_f(bflo(ow[et].x)) * (acc[et][0] * inv); hm[et][1] = sigmoid_f(bfhi(ow[et].x)) * (acc[et][1] * inv);
                hm[et][2] = sigmoid_f(bflo(ow[et].y)) * (acc[et][2] * inv); hm[et][3] = sigmoid_f(bfhi(ow[et].y)) * (acc[et][3] * inv);
                s1 += (hm[et][0] + hm[et][1]) + (hm[et][2] + hm[et][3]);
            }
            s1 += __shfl_xor(s1, 16); s1 += __shfl_xor(s1, 32);
            const float mu = s1 * (1.f / 128.f); float s2 = 0.f;
#pragma unroll
            for (int et = 0; et < 8; ++et)
#pragma unroll
                for (int jj = 0; jj < 4; ++jj) { hm[et][jj] -= mu; s2 += hm[et][jj] * hm[et][jj]; }
            s2 += __shfl_xor(s2, 16); s2 += __shfl_xor(s2, 32);
            const float rstd = __builtin_amdgcn_rsqf(s2 * (1.f / 128.f) + EPS);
            bf16_t* Y = (bf16_t*)(ws + WS_Y);
#pragma unroll
            for (int et = 0; et < 8; ++et) {
                const int e = 16 * et + 4 * fq;
                const f32x4 gn = *(const LAS f32x4*)(lds + 131072 + 512 + (h * 128 + e) * 4);
                const float y0 = hm[et][0] * rstd * gn[0] * silu_f(bflo(zw[et].x)), y1 = hm[et][1] * rstd * gn[1] * silu_f(bfhi(zw[et].x));
                const float y2 = hm[et][2] * rstd * gn[2] * silu_f(bflo(zw[et].y)), y3 = hm[et][3] * rstd * gn[3] * silu_f(bfhi(zw[et].y));
                u32x2 o; o.x = cvt_pk_bf16(y0, y1); o.y = cvt_pk_bf16(y2, y3);
                *(u32x2*)(Y + m * DM + h * 128 + e) = o;
            }
        }
        LDS_BARRIER();
        unit = nxt;
    }
#undef C_LOAD
}

constexpr int FK_P = 144;
constexpr int FL_K = 0, FL_V = 36864, FL_B = 73728;
__device__ __forceinline__ void fox_unit(const Params& p, LAS unsigned char* lds, int bh, int qb, float THR) {
    const int tid = threadIdx.x, lane = tid & 63, wid = tid >> 6, r32 = lane & 31, hi = lane >> 5;
    unsigned char* ws = p.ws;
    const int b = bh >> 3, h = bh & 7;
    const size_t rowbase = (size_t)b * SEQ; const int q0 = qb * 256;
    const bf16_t* U = (const bf16_t*)(ws + WS_U);
    const float* F = (const float*)(ws + WS_FF) + (size_t)bh * SEQ;
    const int NT = 4 * qb + 4;
    const float Fref = F[q0];
    const bf16_t* Qrow = U + (rowbase + q0 + wid * 32 + r32) * NU + UC_FQ + h * 64;
    u32x4 qw[4];
#pragma unroll
    for (int d0 = 0; d0 < 4; ++d0) qw[d0] = *(const u32x4*)(Qrow + d0 * 16 + hi * 8);
    const int srow = tid >> 3, sch = tid & 7;
    const bf16_t* Kg = U + (rowbase + srow) * NU + UC_FK + h * 64 + sch * 8;
    const bf16_t* Vg = Kg + 512;
#define FOX_GLOAD(KR, VR, BR, t) do { KR = *(const u32x4*)(Kg + (size_t)(t) * 64 * NU); VR = *(const u32x4*)(Vg + (size_t)(t) * 64 * NU); BR = F[(t) * 64 + srow]; } while (0)
    u32x4 kA, vA, kB, vB; float bA = 0.f, bB = 0.f;
    FOX_GLOAD(kA, vA, bA, NT - 1);
    FOX_GLOAD(kB, vB, bB, NT - 2);
    int j0;
    {
        LAS int* sj = (LAS int*)(lds + FL_B + 1024);
        if (tid < 128) {
            const bool live = (tid < NT - 4) && (Fref - F[64 * tid + 63] >= -THR);
            const unsigned long long mk = __ballot(live);
            if (lane == 0) sj[wid] = mk ? (__ffsll((long long)mk) - 1 + 64 * wid) : (NT - 4);
        }
        __syncthreads();
        j0 = min(min(sj[0], sj[1]), NT - 4) & ~1;
    }
    bf16x8 qr[4];
    {
        float ss = 0.f;
#pragma unroll
        for (int d0 = 0; d0 < 4; ++d0) {
            ss += (bflo(qw[d0].x) * bflo(qw[d0].x) + bfhi(qw[d0].x) * bfhi(qw[d0].x)) + (bflo(qw[d0].y) * bflo(qw[d0].y) + bfhi(qw[d0].y) * bfhi(qw[d0].y))
                + (bflo(qw[d0].z) * bflo(qw[d0].z) + bfhi(qw[d0].z) * bfhi(qw[d0].z)) + (bflo(qw[d0].w) * bflo(qw[d0].w) + bfhi(qw[d0].w) * bfhi(qw[d0].w)); }
        ss += __shfl_xor(ss, 32);
        const float r = C2 * __builtin_amdgcn_rsqf(ss * (1.f / 64.f) + EPS);
#pragma unroll
        for (int d0 = 0; d0 < 4; ++d0) { const f32x4 g0 = *(const LAS f32x4*)(lds + 131072 + 256 + (d0 * 16 + hi * 8) * 4), g1 = *(const LAS f32x4*)(lds + 131072 + 256 + (d0 * 16 + hi * 8 + 4) * 4);
            u32x4 o; o.x = cvt_pk_bf16(bflo(qw[d0].x) * r * g0[0], bfhi(qw[d0].x) * r * g0[1]); o.y = cvt_pk_bf16(bflo(qw[d0].y) * r * g0[2], bfhi(qw[d0].y) * r * g0[3]);
            o.z = cvt_pk_bf16(bflo(qw[d0].z) * r * g1[0], bfhi(qw[d0].z) * r * g1[1]); o.w = cvt_pk_bf16(bflo(qw[d0].w) * r * g1[2], bfhi(qw[d0].w) * r * g1[3]);
            qr[d0] = __builtin_bit_cast(bf16x8, o); }
    }
#define FOX_LSTORE(KR, VR, BR, buf) do { *(LAS u32x4*)(lds + FL_K + (buf) * 9216 + srow * FK_P + sch * 16) = KR; *(LAS u32x4*)(lds + FL_V + (buf) * 9216 + srow * FK_P + sch * 16) = VR; \
        if (sch == 0) *(LAS float*)(lds + FL_B + (buf) * 256 + srow * 4) = (Fref - BR) * LOG2E; } while (0)
    float m_run = -1.0e30f, l_run = 0.f;
    f32x16 o0, o1;
#pragma unroll
    for (int r = 0; r < 16; ++r) { o0[r] = 0.f; o1[r] = 0.f; }
    const int blk = (lane >> 4) & 1, q4 = (lane & 15) >> 2, pp = lane & 3;
#define FOX_COMPUTE(t, cur) do { if ((t) >= NT - 4 && 64 * ((t) - (NT - 4)) > 32 * wid + 31) break;     \
        const LAS unsigned char* Kt = lds + FL_K + (cur) * 9216; const LAS unsigned char* Vt = lds + FL_V + (cur) * 9216; const LAS float* Bt = (const LAS float*)(lds + FL_B + (cur) * 256); \
        f32x16 p0, p1; \
        _Pragma("unroll") for (int i = 0; i < 4; ++i) { const f32x4 b0 = *(const LAS f32x4*)(Bt + 8 * i + 4 * hi), b1 = *(const LAS f32x4*)(Bt + 32 + 8 * i + 4 * hi); \
            _Pragma("unroll") for (int e = 0; e < 4; ++e) { p0[4 * i + e] = b0[e]; p1[4 * i + e] = b1[e]; } } \
        _Pragma("unroll") for (int d0 = 0; d0 < 4; ++d0) { \
            const bf16x8 ka = *(const LAS bf16x8*)(Kt + r32 * FK_P + (d0 * 16 + hi * 8) * 2); \
            const bf16x8 kb = *(const LAS bf16x8*)(Kt + (r32 + 32) * FK_P + (d0 * 16 + hi * 8) * 2); \
            p0 = __builtin_amdgcn_mfma_f32_32x32x16_bf16(ka, qr[d0], p0, 0, 0, 0); \
            p1 = __builtin_amdgcn_mfma_f32_32x32x16_bf16(kb, qr[d0], p1, 0, 0, 0); } \
        if ((t) >= NT - 4 && 64 * ((t) - (NT - 4)) + 63 > 32 * wid) {     \
            const int qg = wid * 32 + r32; const int kb0 = ((t) - (NT - 4)) * 64 + 4 * hi; \
            _Pragma("unroll") for (int r = 0; r < 16; ++r) { const int kv = kb0 + (r & 3) + 8 * (r >> 2); if (kv > qg) p0[r] = -INFINITY; if (kv + 32 > qg) p1[r] = -INFINITY; } } \
        float mxa = __builtin_fmaxf(__builtin_fmaxf(p0[0], p0[1]), p1[0]), mxb = __builtin_fmaxf(__builtin_fmaxf(p0[2], p0[3]), p1[1]); mxa = __builtin_fmaxf(__builtin_fmaxf(mxa, p1[2]), p1[3]); \
        _Pragma("unroll") for (int r = 4; r < 16; r += 4) { mxa = __builtin_fmaxf(__builtin_fmaxf(mxa, p0[r]), p0[r + 1]); mxb = __builtin_fmaxf(__builtin_fmaxf(mxb, p0[r + 2]), p0[r + 3]); \
            mxa = __builtin_fmaxf(__builtin_fmaxf(mxa, p1[r]), p1[r + 1]); mxb = __builtin_fmaxf(__builtin_fmaxf(mxb, p1[r + 2]), p1[r + 3]); } \
        float mx = __builtin_fmaxf(mxa, mxb); \
        mx = fmaxf(mx, __shfl_xor(mx, 32)); \
        if (__any(mx > m_run)) {     \
            const float m_new = fmaxf(m_run, mx); const float alpha = __builtin_amdgcn_exp2f(m_run - m_new); m_run = m_new; l_run *= alpha; \
            _Pragma("unroll") for (int r = 0; r < 16; ++r) { o0[r] *= alpha; o1[r] *= alpha; } } \
        p0 = p0 - m_run; p1 = p1 - m_run;     \
        _Pragma("unroll") for (int r = 0; r < 16; ++r) { p0[r] = __builtin_amdgcn_exp2f(p0[r]); p1[r] = __builtin_amdgcn_exp2f(p1[r]); } \
        { const f32x16 sv = p0 + p1; const f32x4 s4 = (f32x4){sv[0], sv[1], sv[2], sv[3]} + (f32x4){sv[4], sv[5], sv[6], sv[7]} + (f32x4){sv[8], sv[9], sv[10], sv[11]} + (f32x4){sv[12], sv[13], sv[14], sv[15]}; \
          l_run += (s4[0] + s4[1]) + (s4[2] + s4[3]); } \
        u32x4 pw[4]; \
        _Pragma("unroll") for (int i = 0; i < 4; ++i) { pw[0][i] = cvt_pk_bf16_c(p0[2 * i], p0[2 * i + 1]); pw[1][i] = cvt_pk_bf16_c(p0[8 + 2 * i], p0[8 + 2 * i + 1]);     \
                                      pw[2][i] = cvt_pk_bf16_c(p1[2 * i], p1[2 * i + 1]); pw[3][i] = cvt_pk_bf16_c(p1[8 + 2 * i], p1[8 + 2 * i + 1]); } \
        _Pragma("unroll") for (int ks = 0; ks < 4; ++ks) { \
            const bf16x8 pb = __builtin_bit_cast(bf16x8, pw[ks]); \
            const LAS unsigned char* v0 = Vt + (16 * ks + 4 * hi + q4) * FK_P + (16 * blk + 4 * pp) * 2; \
            const bf16x8 va0 = cat8(tr16(v0), tr16(v0 + 8 * FK_P)); \
            const bf16x8 va1 = cat8(tr16(v0 + 64), tr16(v0 + 8 * FK_P + 64)); \
            o0 = __builtin_amdgcn_mfma_f32_32x32x16_bf16(va0, pb, o0, 0, 0, 0); \
            o1 = __builtin_amdgcn_mfma_f32_32x32x16_bf16(va1, pb, o1, 0, 0, 0); } \
    } while (0)
    const float B2 = (THR - 16.f) * 0.5f * LOG2E, M2 = 16.f * LOG2E;
    LAS int* stopit = (LAS int*)(lds + FL_B + 1280);
    if (tid < 8) stopit[tid] = 0x7fffffff;
    bool wdone = false;
    FOX_LSTORE(kA, vA, bA, 0);
    FOX_LSTORE(kB, vB, bB, 1);
    __syncthreads();
#pragma unroll 1
    for (int t = NT - 1; t > j0; t -= 2) {
        const int step = (NT - 1 - t) >> 1, set = step & 1;
        const bool more = t - 2 > j0;
        float fnx = 0.f;
        if (more) { FOX_GLOAD(kA, vA, bA, t - 2); FOX_GLOAD(kB, vB, bB, t - 3); fnx = F[64 * (t - 2) + 63]; }
        const int c0 = set * 2, n0 = 2 - c0;
        if (!wdone) { FOX_COMPUTE(t, c0); FOX_COMPUTE(t - 1, c0 + 1); }
        if (more) { FOX_LSTORE(kA, vA, bA, n0); FOX_LSTORE(kB, vB, bB, n0 + 1); }
        if (more && !wdone && t < NT - 2) {
            float mm = m_run;
#pragma unroll
            for (int o = 1; o < 64; o <<= 1) mm = fminf(mm, __shfl_xor(mm, o));
            if ((Fref - fnx) * LOG2E + B2 < mm - M2) { wdone = true; if (lane == 0) stopit[wid] = step; }
        }
        LDS_BARRIER();
        { const u32x4 s0 = *(const LAS u32x4*)stopit, s1 = *(const LAS u32x4*)(stopit + 4);
          if (max(max(max(s0.x, s0.y), max(s0.z, s0.w)), max(max(s1.x, s1.y), max(s1.z, s1.w))) <= (unsigned)step) break; }
    }
#undef FOX_GLOAD
#undef FOX_LSTORE
#undef FOX_COMPUTE
    l_run += __shfl_xor(l_run, 32);
    const float inv = __builtin_amdgcn_rcpf(l_run);
    const size_t m = rowbase + q0 + wid * 32 + r32;
    bf16_t* Y = (bf16_t*)(ws + WS_Y);
#pragma unroll
    for (int dh = 0; dh < 2; ++dh)
#pragma unroll
        for (int i = 0; i < 4; ++i) {
            const int d = dh * 32 + 8 * i + 4 * hi;
            const u32x2 zw = *(const u32x2*)(U + m * NU + UC_FZ + h * 64 + d);
            const float a0 = (dh ? o1[4 * i + 0] : o0[4 * i + 0]) * inv, a1 = (dh ? o1[4 * i + 1] : o0[4 * i + 1]) * inv, a2 = (dh ? o1[4 * i + 2] : o0[4 * i + 2]) * inv, a3 = (dh ? o1[4 * i + 3] : o0[4 * i + 3]) * inv;
            u32x2 o; o.x = cvt_pk_bf16(a0 * silu_f(bflo(zw.x)), a1 * silu_f(bfhi(zw.x))); o.y = cvt_pk_bf16(a2 * silu_f(bflo(zw.y)), a3 * silu_f(bfhi(zw.y)));
            *(u32x2*)(Y + m * DM + 512 + h * 64 + d) = o;
        }
}

#define XB_TMO      128
#define XB_XCNT(j)  (256  + 64 * (j))
#define XB_XSUB(j)  (1280 + 64 * (j))
#define XB_XGEN(j)  (2304 + 64 * (j))
#define XB_TOP      3328
#define XB_TOPGEN   3392
#define XCD_BAR_WORDS 3456
#define XB_SPIN_CAP (1u << 22)
__device__ __forceinline__ unsigned xb_ld(unsigned* p)              { return __hip_atomic_load(p, __ATOMIC_RELAXED, __HIP_MEMORY_SCOPE_AGENT); }
__device__ __forceinline__ unsigned xb_add(unsigned* p, unsigned v) { return __hip_atomic_fetch_add(p, v, __ATOMIC_RELAXED, __HIP_MEMORY_SCOPE_AGENT); }
__device__ __forceinline__ unsigned xb_xcc_id() { return (unsigned)__builtin_amdgcn_s_getreg((3 << 11) | 20) & 0xFu; }
#define XB_SPIN(cond, bar) do { unsigned _sp = 0; while (cond) { __builtin_amdgcn_s_sleep(1); \
    if ((++_sp & 255u) == 0u) { if (xb_ld(&(bar)[XB_TMO])) break; if (_sp > XB_SPIN_CAP) { atomicAdd(&(bar)[XB_TMO], 1u); break; } } } } while (0)
struct XcdBarrier { unsigned* bar; unsigned x; volatile LAS unsigned* st; };
__device__ __forceinline__ XcdBarrier xcd_barrier_post(unsigned* bar, volatile LAS unsigned* st) {
    XcdBarrier b; b.bar = bar; b.x = xb_xcc_id(); b.st = st;
    if (threadIdx.x == 0) (void)xb_add(&bar[XB_XCNT(b.x)], 1u);
    return b;
}
__device__ __forceinline__ void xcd_barrier_complete(unsigned* bar, unsigned x, unsigned& nloc, unsigned& nx) {
    const unsigned G = gridDim.x * gridDim.y * gridDim.z;
    unsigned sum, cnt, mine, sp = 0u;
    for (;;) {
        sum = 0u; cnt = 0u; mine = 0u;
#pragma unroll
        for (unsigned j = 0; j < 16; ++j) { const unsigned c = xb_ld(&bar[XB_XCNT(j)]); sum += c; cnt += (c > 0u) ? 1u : 0u; mine = (j == x) ? c : mine; }
        if (sum == G) break;
        __builtin_amdgcn_s_sleep(1);
        if ((++sp & 255u) == 0u) { if (xb_ld(&bar[XB_TMO])) break; if (sp > XB_SPIN_CAP) { atomicAdd(&bar[XB_TMO], 1u); break; } }
    }
    nloc = mine > 0u ? mine : 1u; nx = cnt > 0u ? cnt : 1u;
}
__device__ __forceinline__ void xcd_barrier(const XcdBarrier& b) {
    asm volatile("s_waitcnt vmcnt(0)" ::: "memory");
    __syncthreads();
    if (threadIdx.x == 0) {
        unsigned* bar = b.bar;
        __builtin_amdgcn_s_waitcnt(0);
        unsigned nloc = b.st[0], nx = b.st[1];
        if (nloc == 0u) { xcd_barrier_complete(bar, b.x, nloc, nx); b.st[0] = nloc; b.st[1] = nx; }
        const unsigned old = xb_add(&bar[XB_XSUB(b.x)], 1u);
        const unsigned gen = old / nloc;
        if (old + 1u == (gen + 1u) * nloc) {
            __builtin_amdgcn_fence(__ATOMIC_RELEASE, "agent");
            asm volatile("s_waitcnt vmcnt(0)" ::: "memory");
            const unsigned og = xb_add(&bar[XB_TOP], 1u);
            const unsigned tg = og / nx;
            if (og + 1u == (tg + 1u) * nx) xb_add(&bar[XB_TOPGEN], 1u);
            else XB_SPIN(xb_ld(&bar[XB_TOPGEN]) == tg, bar);
            __builtin_amdgcn_fence(__ATOMIC_ACQUIRE, "agent");
            xb_add(&bar[XB_XGEN(b.x)], 1u);
            asm volatile("s_waitcnt vmcnt(0)" ::: "memory");
        } else {
            XB_SPIN(xb_ld(&bar[XB_XGEN(b.x)]) == gen, bar);
            __builtin_amdgcn_fence(__ATOMIC_ACQUIRE, "agent");
            asm volatile("s_waitcnt vmcnt(0)" ::: "memory");
        }
    }
    __syncthreads();
}
#define GRID_SYNC() xcd_barrier(xbar)
#define GRID_SYNC_CG() do { asm volatile("s_waitcnt vmcnt(0) lgkmcnt(0)" ::: "memory"); __builtin_amdgcn_fence(__ATOMIC_RELEASE, "agent"); asm volatile("s_waitcnt vmcnt(0)" ::: "memory"); \
    grid.sync(); __builtin_amdgcn_fence(__ATOMIC_ACQUIRE, "agent"); asm volatile("s_waitcnt vmcnt(0)" ::: "memory"); __syncthreads(); } while (0)
__global__ void __launch_bounds__(512, 2) hymba_fwd(Params p) {
    extern __shared__ __attribute__((aligned(16))) unsigned char lds_raw[];
    LAS unsigned char* lds = (LAS unsigned char*)lds_raw;
    cg::grid_group grid = cg::this_grid();
    unsigned char* ws = p.ws;
    const int G = gridDim.x;
    if (threadIdx.x < 2) ((volatile LAS unsigned*)(lds + 131072 + 64))[threadIdx.x] = 0u;
    __syncthreads();
    if (blockIdx.x == 0) for (int i = threadIdx.x; i < 32768 / 16; i += 512) ((u32x4*)ws)[i] = (u32x4){0u, 0u, 0u, 0u};

    phase0(p, lds);
    GRID_SYNC_CG();
    const XcdBarrier xbar = xcd_barrier_post((unsigned*)(ws + 4096), (volatile LAS unsigned*)(lds + 131072 + 64));
    phase1a(p, lds);
    GRID_SYNC();
    {
        pg8::Gemm g{(const bf16_t*)(ws + WS_H), (const bf16_t*)(ws + WS_WTIN), T_, NU, DM}; pg8::StaticOrder S; S.init(T_, NU, G, (int)blockIdx.x);
        pg8::EpiU E{(bf16_t*)(ws + WS_U), NU};
        pg8::gemm_phase<pg8::EpiU, pg8::StaticOrder, true>(lds, g, S, E);
    }
    GRID_SYNC();
    phase2a(p, lds);
    GRID_SYNC();
    mlstm_a_phase(p, lds, (int)blockIdx.x, G);
    GRID_SYNC();
    {
        float THR;
        { const int lane = threadIdx.x & 63; float a = fabsf(p.gq[lane]), b = fabsf(p.gk[lane]);
#pragma unroll
          for (int o = 1; o < 64; o <<= 1) { a = fmaxf(a, __shfl_xor(a, o)); b = fmaxf(b, __shfl_xor(b, o)); }
          THR = 16.f * a * b + 16.f; }
        unsigned* qctr = (unsigned*)ws + 16; unsigned* sdone = (unsigned*)ws + 32;
        LAS int* qslot = (LAS int*)(lds + 131072);
        if (threadIdx.x < 64) *(LAS float*)(lds + 131072 + 256 + threadIdx.x * 4) = p.gq[threadIdx.x];
        *(LAS float*)(lds + 131072 + 512 + threadIdx.x * 4) = p.mnorm_g[threadIdx.x];
        for (;;) {
            if (threadIdx.x == 0) *qslot = (int)__hip_atomic_fetch_add(qctr, 1u, __ATOMIC_RELAXED, __HIP_MEMORY_SCOPE_AGENT);
            __syncthreads();
            const int it = *qslot;
            __syncthreads();
            constexpr int C_BASE = SCAN_ITEMS + 1024;
            if (it >= C_BASE) {
                if (it < C_BASE + 2048) {
                    if (threadIdx.x == 0) { while (__hip_atomic_load(sdone, __ATOMIC_RELAXED, __HIP_MEMORY_SCOPE_AGENT) < (unsigned)SCAN_ITEMS) __builtin_amdgcn_s_sleep(2);
                        __builtin_amdgcn_fence(__ATOMIC_ACQUIRE, "agent"); asm volatile("s_waitcnt vmcnt(0)" ::: "memory"); }
                    __syncthreads();
                    mlstm_c_phase(p, lds, it - C_BASE, qctr, qslot, C_BASE);
                }
                break;
            }
            if (it >= 128 && it < 128 + SCAN_ITEMS) {
                mlstm_scan(p, it - 128);
                asm volatile("s_waitcnt vmcnt(0)" ::: "memory");
                __syncthreads();
                if (threadIdx.x == 0) { __builtin_amdgcn_fence(__ATOMIC_RELEASE, "agent"); asm volatile("s_waitcnt vmcnt(0)" ::: "memory"); (void)__hip_atomic_fetch_add(sdone, 1u, __ATOMIC_RELAXED, __HIP_MEMORY_SCOPE_AGENT); }
            }
            else { const int f = (it < 128) ? it : it - SCAN_ITEMS; const int h = 7 - (f >> 7), r = f & 127, b = r & 3, qb = 31 - (r >> 2); fox_unit(p, lds, b * 8 + h, qb, THR); }
        }
    }
    GRID_SYNC();
    {
        pg8::Gemm g{(const bf16_t*)(ws + WS_Y), (const bf16_t*)(ws + WS_WTOUT), T_, DM, DM}; pg8::StaticOrder S; S.init(T_, DM, G, (int)blockIdx.x);
        pg8::EpiOut E{p.x, (const float*)(ws + WS_MOD), p.out};
        pg8::gemm_phase<pg8::EpiOut, pg8::StaticOrder, true>(lds, g, S, E);
    }
}

extern "C" void kernel_launch(void* const* d_in, const int* in_sizes, int n_in, void* d_out, int out_size, void* d_ws, size_t ws_size, hipStream_t stream) {
    static int grid = 0;
    if (grid == 0) {
        if (n_in != 15 || in_sizes[0] != T_ * DM || out_size != T_ * DM || ws_size < WS_END) { fprintf(stderr, "kernel_launch: unexpected shapes (n_in %d, in0 %d, out %d, ws %zu)\n", n_in, n_in > 0 ? in_sizes[0] : -1, out_size, ws_size); grid = -1; return; }
        int dev = 0, cus = 0, per_cu = 0;
        hipGetDevice(&dev);
        hipDeviceGetAttribute(&cus, hipDeviceAttributeMultiprocessorCount, dev);
        if (hipFuncSetAttribute((const void*)hymba_fwd, hipFuncAttributeMaxDynamicSharedMemorySize, LDS_BYTES) != hipSuccess) { fprintf(stderr, "kernel_launch: hipFuncSetAttribute failed\n"); grid = -1; return; }
        hipOccupancyMaxActiveBlocksPerMultiprocessor(&per_cu, (const void*)hymba_fwd, 512, LDS_BYTES);
        if (per_cu < 1) { fprintf(stderr, "kernel_launch: occupancy query says %d blocks per CU\n", per_cu); per_cu = 1; }
        (void)hipGetLastError();
        grid = cus * 1;
    }
    if (grid < 0) return;
    Params p{};
    p.x = (const float*)d_in[0]; p.c = (const float*)d_in[1]; p.norm_g = (const float*)d_in[2]; p.w_ada = (const float*)d_in[3]; p.b_ada = (const float*)d_in[4];
    p.w_in = (const float*)d_in[5]; p.conv_w = (const float*)d_in[6]; p.conv_b = (const float*)d_in[7]; p.b_ig = (const float*)d_in[8]; p.b_fm = (const float*)d_in[9];
    p.mnorm_g = (const float*)d_in[10]; p.b_ff = (const float*)d_in[11]; p.gq = (const float*)d_in[12]; p.gk = (const float*)d_in[13]; p.w_out = (const float*)d_in[14];
    p.out = (float*)d_out; p.ws = (unsigned char*)d_ws;
    void* args[] = {&p};
    hipError_t e = hipLaunchCooperativeKernel((const void*)hymba_fwd, dim3(grid), dim3(512), args, LDS_BYTES, stream);
    if (e != hipSuccess) fprintf(stderr, "cooperative launch failed: %s (grid %d)\n", hipGetErrorString(e), grid);
}
```

```cpp
#include <hip/hip_runtime.h>
#include <hip/hip_cooperative_groups.h>
#include <cstdio>
#include <cstdint>
#include <cmath>
namespace cg = cooperative_groups;

#define LAS __attribute__((address_space(3)))
typedef unsigned short bf16_t;
typedef short bf16x8 __attribute__((ext_vector_type(8)));
typedef short s16x4 __attribute__((ext_vector_type(4)));
typedef float f32x4 __attribute__((ext_vector_type(4)));
typedef float f32x16 __attribute__((ext_vector_type(16)));
typedef unsigned u32x4 __attribute__((ext_vector_type(4)));
typedef unsigned u32x2 __attribute__((ext_vector_type(2)));

constexpr int T_ = 32768, SEQ = 8192, DM = 1024, DIN = 4624, NU = 4608;
constexpr int UC_MV = 1024, UC_MO = 1536, UC_MZ = 2048, UC_FQ = 2560, UC_FK = 3072, UC_FV = 3584, UC_FZ = 4096;
constexpr float C2 = 0.125f * 1.4426950408889634f;
constexpr float LOG2E = 1.4426950408889634f;
constexpr float EPS = 1e-6f;
constexpr int CE = 144;
constexpr int CST_ELEMS = CE * 128;

constexpr size_t MiB = 1u << 20;
constexpr size_t WS_MOD = 1 * MiB;
constexpr size_t WS_WG = 1 * MiB + 65536;
constexpr size_t WS_WTIN = 2 * MiB;
constexpr size_t WS_WTOUT = 12 * MiB;
constexpr size_t WS_GATES = 14 * MiB;
constexpr size_t WS_H = 16 * MiB;
constexpr size_t WS_FF = 80 * MiB;
constexpr size_t WS_MG = 81 * MiB;
constexpr size_t WS_MGR = 81 * MiB + 512 * 1024;
constexpr size_t WS_MFL = 82 * MiB;
constexpr size_t WS_U = 84 * MiB;
constexpr size_t WS_CST = 372 * MiB;
constexpr size_t WS_Y = 444 * MiB;
constexpr size_t WS_QC = 16 * MiB, WS_KC = 48 * MiB;
constexpr size_t WS_END = 508 * MiB;

constexpr int LDS_BYTES = 135168;

struct Params {
    const float *x, *c, *norm_g, *w_ada, *b_ada, *w_in, *conv_w, *conv_b, *b_ig, *b_fm, *mnorm_g, *b_ff, *gq, *gk, *w_out;
    float* out; unsigned char* ws;
};

__device__ __forceinline__ unsigned cvt_pk_bf16(float lo, float hi) { unsigned r; asm volatile("v_cvt_pk_bf16_f32 %0, %1, %2" : "=v"(r) : "v"(lo), "v"(hi)); return r; }
typedef float f32x2_t __attribute__((ext_vector_type(2))); typedef __bf16 bf16x2_t __attribute__((ext_vector_type(2)));
__device__ __forceinline__ unsigned cvt_pk_bf16_c(float lo, float hi) { f32x2_t v = {lo, hi}; bf16x2_t b = __builtin_convertvector(v, bf16x2_t); return __builtin_bit_cast(unsigned, b); }
__device__ __forceinline__ float bflo(unsigned w) { return __uint_as_float(w << 16); }
__device__ __forceinline__ float bfhi(unsigned w) { return __uint_as_float(w & 0xffff0000u); }
__device__ __forceinline__ float wave_sum(float v) {
#pragma unroll
    for (int o = 1; o < 64; o <<= 1) v += __shfl_xor(v, o);
    return v;
}
__device__ __forceinline__ float sigmoid_f(float x) { return __builtin_amdgcn_rcpf(1.f + __expf(-x)); }
__device__ __forceinline__ float silu_f(float x) { return x * __builtin_amdgcn_rcpf(1.f + __expf(-x)); }
__device__ __forceinline__ float logsigmoid_f(float z) { const float e = __expf(-fabsf(z)); return fminf(z, 0.f) - __logf(1.0f + e); }
#define LDS_BARRIER() asm volatile("s_waitcnt lgkmcnt(0)\n\ts_barrier" ::: "memory")
typedef short v4i16_t __attribute__((ext_vector_type(4)));
__device__ __forceinline__ s16x4 tr16(const LAS unsigned char* p) { return __builtin_bit_cast(s16x4, __builtin_amdgcn_ds_read_tr16_b64_v4i16((LAS v4i16_t*)p)); }
__device__ __forceinline__ bf16x8 cat8(s16x4 a, s16x4 b) { return (bf16x8){a[0], a[1], a[2], a[3], b[0], b[1], b[2], b[3]}; }

namespace pg8 {
#define PG8_LAS __attribute__((address_space(3)))
constexpr int BM = 256, BK = 64, HALF = 128, HTB = HALF * BK * 2, NXCD = 8, WGM = 8;
__host__ __device__ __forceinline__ int lds_byte(int r, int c) { const int st = (r >> 4) * 2 + (c >> 5), rr = r & 15, cc = c & 31, ob = rr * 64 + cc * 2; return st * 1024 + (ob ^ (((ob >> 9) & 1) << 5)); }
__host__ __device__ __forceinline__ void stage_rc(int b, int& R, int& C) { const int st = b / 1024, sb = b % 1024, swz = sb ^ (((sb >> 9) & 1) << 5); R = (st >> 1) * 16 + swz / 64; C = (st & 1) * 32 + (swz % 64) / 2; }
__host__ __device__ __forceinline__ int perm32(int rho) { const int n = rho >> 4, i = rho & 15; return 8 * (i >> 2) + 4 * n + (i & 3); }
struct Unit { int pm, pn; };
struct Gemm { const bf16_t* A; const bf16_t* Bt; int M, N, K; };
struct StaticOrder {
    int nM, nN, nwg, G, c;
    __host__ __device__ void init(int M, int N, int G_, int c_) { nM = M / BM; nN = N / BM; nwg = nM * nN; G = G_; c = c_; }
    __host__ __device__ bool next(int i, Unit& u) const {
        const long L = (long)i * G + c; if (L >= nwg) return false;
        int wgid = (int)L; { const int q = nwg / NXCD, r = nwg % NXCD, xcd = wgid % NXCD, off = wgid / NXCD; wgid = (xcd < r ? xcd * (q + 1) : r * (q + 1) + (xcd - r) * q) + off; }
        const int nig = WGM * nN, gid = wgid / nig, fm = gid * WGM, gsz = (nM - fm) < WGM ? (nM - fm) : WGM;
        u.pm = fm + ((wgid % nig) % gsz); u.pn = (wgid % nig) / gsz; return true;
    }
    __device__ __forceinline__ void a_ready(const Unit&) const {}
    __device__ __forceinline__ void done(const Unit&) const {}
};
struct EpiU {
    static constexpr bool PERM = true, AFTER_DRAIN = false;
    bf16_t* O; int ldc;
    __device__ __forceinline__ void operator()(const f32x4 (&acc)[2][2][4][2], const Unit& u, int wr, int wc, int fr, int fq) const {
        const int row0 = u.pm * BM + wr * 64 + fr; const int col0 = u.pn * BM + wc * 32 + 8 * fq;
        asm volatile("s_nop 15\n\ts_nop 7" ::: "memory");
#pragma unroll
        for (int ai = 0; ai < 2; ++ai)
#pragma unroll
            for (int m = 0; m < 4; ++m) { bf16_t* rowp = O + (size_t)(row0 + ai * HALF + m * 16) * ldc + col0;
#pragma unroll
                for (int bj = 0; bj < 2; ++bj) { const f32x4 v0 = acc[ai][bj][m][0], v1 = acc[ai][bj][m][1];
                    u32x4 w; w.x = cvt_pk_bf16(v0[0], v0[1]); w.y = cvt_pk_bf16(v0[2], v0[3]); w.z = cvt_pk_bf16(v1[0], v1[1]); w.w = cvt_pk_bf16(v1[2], v1[3]);
                    *(u32x4*)(rowp + bj * HALF) = w; } }
    }
};
struct EpiOut {
    static constexpr bool PERM = true, AFTER_DRAIN = false;
    const float* x; const float* mod; float* out;
    __device__ __forceinline__ void operator()(const f32x4 (&acc)[2][2][4][2], const Unit& u, int wr, int wc, int fr, int fq) const {
        const int row0 = u.pm * BM + wr * 64 + fr; const int col0 = u.pn * BM + wc * 32 + 8 * fq;
        const int b = (u.pm * BM) >> 13;
        f32x4 gv[2][2];
#pragma unroll
        for (int bj = 0; bj < 2; ++bj)
#pragma unroll
            for (int n = 0; n < 2; ++n) gv[bj][n] = *(const f32x4*)(mod + b * 3072 + 2048 + col0 + bj * HALF + 4 * n);
#pragma unroll
        for (int ai = 0; ai < 2; ++ai)
#pragma unroll
            for (int mp = 0; mp < 2; ++mp) {
                f32x4 xv[2][2][2];
#pragma unroll
                for (int mm = 0; mm < 2; ++mm) { const size_t ro = (size_t)(row0 + ai * HALF + (2 * mp + mm) * 16) * DM + col0;
#pragma unroll
                    for (int bj = 0; bj < 2; ++bj)
#pragma unroll
                        for (int n = 0; n < 2; ++n) xv[mm][bj][n] = *(const f32x4*)(x + ro + bj * HALF + 4 * n); }
                __builtin_amdgcn_sched_barrier(0);
#pragma unroll
                for (int mm = 0; mm < 2; ++mm) { const size_t ro = (size_t)(row0 + ai * HALF + (2 * mp + mm) * 16) * DM + col0;
#pragma unroll
                    for (int bj = 0; bj < 2; ++bj)
#pragma unroll
                        for (int n = 0; n < 2; ++n) *(f32x4*)(out + ro + bj * HALF + 4 * n) = xv[mm][bj][n] + gv[bj][n] * acc[ai][bj][2 * mp + mm][n]; }
            }
    }
};

template <class Epi, class Sched, bool ALIGN_EPI = false>
__device__ __forceinline__ void gemm_phase(PG8_LAS unsigned char* lds, const Gemm g, const Sched& S, const Epi& E) {
    const int tid = threadIdx.x, wid = __builtin_amdgcn_readfirstlane(tid >> 6), lane = tid & 63, wr = wid >> 2, wc = wid & 3, fr = lane & 15, fq = lane >> 4;
    const int K = g.K, nt = K / BK;
    unsigned voffA[2], voffB[2];
#pragma unroll
    for (int i = 0; i < 2; ++i) { int R, C; stage_rc(tid * 16 + i * 8192, R, C); const int Rb = Epi::PERM ? ((R & ~31) + perm32(R & 31)) : R;
        voffA[i] = (unsigned)(R * K + C) * 2u; voffB[i] = (unsigned)(Rb * K + C) * 2u; }
    const size_t kstep = (size_t)(BK * 2);
    const size_t hstep = (size_t)HALF * K * 2;
    const size_t tstep = 2 * hstep;
    const unsigned ldsw = (unsigned)wid * 1024u;
    const int aoff = lds_byte(wr * 64 + fr, fq * 8), boff = lds_byte(wc * 32 + fr, fq * 8);
#define PG8_SA(b, h) (((b) * 2 + (h)) * HTB)
#define PG8_SB(b, h) ((4 + (b) * 2 + (h)) * HTB)
#define PG8_STAGE(bufoff, gbase, voff) do { _Pragma("unroll") for (int _i = 0; _i < 2; ++_i) \
        __builtin_amdgcn_global_load_lds((const unsigned*)((const char*)(gbase) + (voff)[_i]), (PG8_LAS unsigned*)(lds + (bufoff) + ldsw + _i * 8192), 16, 0, 0); } while (0)
#define PG8_LDA(dst, b, h) do { _Pragma("unroll") for (int m = 0; m < 4; ++m) _Pragma("unroll") for (int k = 0; k < 2; ++k) dst[m][k] = *(const PG8_LAS bf16x8*)(lds + PG8_SA(b, h) + aoff + m * 2048 + k * 1024); } while (0)
#define PG8_LDB(dst, b, h) do { _Pragma("unroll") for (int n = 0; n < 2; ++n) _Pragma("unroll") for (int k = 0; k < 2; ++k) dst[n][k] = *(const PG8_LAS bf16x8*)(lds + PG8_SB(b, h) + boff + n * 2048 + k * 1024); } while (0)
#define PG8_MMA(ai, bj, At, Bt) do { __builtin_amdgcn_s_setprio(1); _Pragma("unroll") for (int m = 0; m < 4; ++m) _Pragma("unroll") for (int n = 0; n < 2; ++n) _Pragma("unroll") for (int k = 0; k < 2; ++k) \
        acc[ai][bj][m][n] = __builtin_amdgcn_mfma_f32_16x16x32_bf16(Bt[n][k], At[m][k], acc[ai][bj][m][n], 0, 0, 0); __builtin_amdgcn_s_setprio(0); } while (0)
#define PG8_WAIT_V(n) asm volatile("s_waitcnt vmcnt(" #n ")" ::: "memory")
#define PG8_WAIT_L(n) asm volatile("s_waitcnt lgkmcnt(" #n ")" ::: "memory")
#define PG8_BAR __builtin_amdgcn_s_barrier()
#define PG8_SCHED __builtin_amdgcn_sched_barrier(0)
    Unit cur, nxt; int ui = 0;
    if (!S.next(0, cur)) return;
    f32x4 acc[2][2][4][2];
#pragma unroll
    for (int a = 0; a < 2; ++a)
#pragma unroll
        for (int b = 0; b < 2; ++b)
#pragma unroll
            for (int m = 0; m < 4; ++m)
#pragma unroll
                for (int n = 0; n < 2; ++n) acc[a][b][m][n] = (f32x4){0.f, 0.f, 0.f, 0.f};
    bf16x8 At[4][2], B0[2][2], B1[2][2];
    const char* cA = (const char*)g.A + (size_t)cur.pm * tstep; const char* cB = (const char*)g.Bt + (size_t)cur.pn * tstep;
    S.a_ready(cur);
    PG8_STAGE(PG8_SB(0, 0), cB, voffB); PG8_STAGE(PG8_SB(0, 1), cB + hstep, voffB); PG8_STAGE(PG8_SA(0, 0), cA, voffA); PG8_STAGE(PG8_SA(0, 1), cA + hstep, voffA);
    if (wr == 1) PG8_BAR;
    PG8_WAIT_V(2); PG8_BAR;
    PG8_STAGE(PG8_SB(1, 0), cB + kstep, voffB); PG8_STAGE(PG8_SA(1, 0), cA + kstep, voffA); PG8_STAGE(PG8_SB(1, 1), cB + hstep + kstep, voffB);
    PG8_WAIT_V(6); PG8_BAR;
    for (;;) {
        const bool has_next = S.next(ui + 1, nxt);
        const char* nA = has_next ? (const char*)g.A + (size_t)nxt.pm * tstep : cA; const char* nB = has_next ? (const char*)g.Bt + (size_t)nxt.pn * tstep : cB;
        for (int t = 0; t < nt; t += 2) {
            const bool last = (t == nt - 2);
            const char* a1 = cA + (size_t)(t + 1) * kstep;
            const char* a2 = last ? nA : cA + (size_t)(t + 2) * kstep; const char* b2 = last ? nB : cB + (size_t)(t + 2) * kstep;
            const char* a3 = a2 + kstep; const char* b3 = b2 + kstep;
            if (last && has_next) S.a_ready(nxt);
            PG8_LDB(B0, 0, 0); PG8_LDB(B1, 0, 1); PG8_SCHED; PG8_LDA(At, 0, 0); PG8_STAGE(PG8_SA(1, 1), a1 + hstep, voffA);
            PG8_WAIT_V(8); PG8_WAIT_L(0); PG8_BAR; PG8_MMA(0, 0, At, B0); PG8_MMA(0, 1, At, B1); PG8_BAR; PG8_SCHED;
            PG8_LDA(At, 0, 1); PG8_STAGE(PG8_SB(0, 0), b2, voffB); PG8_STAGE(PG8_SB(0, 1), b2 + hstep, voffB); PG8_STAGE(PG8_SA(0, 0), a2, voffA);
            PG8_WAIT_V(8); PG8_WAIT_L(0); PG8_BAR; PG8_MMA(1, 0, At, B0); PG8_MMA(1, 1, At, B1); PG8_BAR; PG8_SCHED;
            PG8_LDB(B0, 1, 0); PG8_LDB(B1, 1, 1); PG8_SCHED; PG8_LDA(At, 1, 0); PG8_STAGE(PG8_SA(0, 1), a2 + hstep, voffA);
            PG8_WAIT_V(8); PG8_WAIT_L(0); PG8_BAR; PG8_MMA(0, 0, At, B0); PG8_MMA(0, 1, At, B1); PG8_BAR; PG8_SCHED;
            PG8_LDA(At, 1, 1); PG8_STAGE(PG8_SB(1, 0), b3, voffB); PG8_STAGE(PG8_SB(1, 1), b3 + hstep, voffB); PG8_STAGE(PG8_SA(1, 0), a3, voffA);
            PG8_WAIT_V(8); PG8_WAIT_L(0); PG8_BAR; PG8_MMA(1, 0, At, B0); PG8_MMA(1, 1, At, B1); PG8_BAR; PG8_SCHED;
        }
        if constexpr (ALIGN_EPI) { if (wr == 0) PG8_BAR; }
        E(acc, cur, wr, wc, fr, fq); S.done(cur);
        if (!has_next) break;
#pragma unroll
        for (int a = 0; a < 2; ++a)
#pragma unroll
            for (int b = 0; b < 2; ++b)
#pragma unroll
                for (int m = 0; m < 4; ++m)
#pragma unroll
                    for (int n = 0; n < 2; ++n) acc[a][b][m][n] = (f32x4){0.f, 0.f, 0.f, 0.f};
        cur = nxt; cA = nA; cB = nB; ++ui;
        if constexpr (ALIGN_EPI) { if (wr == 1) PG8_BAR; }
    }
    PG8_WAIT_V(0);
    if constexpr (!ALIGN_EPI) { if (wr == 0) PG8_BAR; }
    PG8_BAR;
#undef PG8_SA
#undef PG8_SB
#undef PG8_STAGE
#undef PG8_LDA
#undef PG8_LDB
#undef PG8_MMA
#undef PG8_WAIT_V
#undef PG8_WAIT_L
#undef PG8_BAR
#undef PG8_SCHED
}
}

__device__ __forceinline__ void p0_transpose_item(const float* W, int Nsrc, int K, bf16_t* WT, int src0, int dst0, int k0, LAS float* scr, int lane) {
#pragma unroll 8
    for (int i = 0; i < 32; ++i) { const int kk = 2 * i + (lane >> 5); scr[kk * 33 + (lane & 31)] = W[(size_t)(k0 + kk) * Nsrc + src0 + (lane & 31)]; }
    asm volatile("s_waitcnt lgkmcnt(0)" ::: "memory");
    const int c = lane & 7;
#pragma unroll
    for (int j = 0; j < 4; ++j) { const int n = (lane >> 3) + 8 * j; const LAS float* s = scr + (8 * c) * 33 + n;
        u32x4 o; o.x = cvt_pk_bf16(s[0 * 33], s[1 * 33]); o.y = cvt_pk_bf16(s[2 * 33], s[3 * 33]); o.z = cvt_pk_bf16(s[4 * 33], s[5 * 33]); o.w = cvt_pk_bf16(s[6 * 33], s[7 * 33]);
        *(u32x4*)(WT + (size_t)(dst0 + n) * K + k0 + 8 * c) = o; }
    asm volatile("s_waitcnt lgkmcnt(0)" ::: "memory");
}

__device__ __forceinline__ void p0_weights(const Params& p, LAS unsigned char* lds) {
    const int tid = threadIdx.x, lane = tid & 63, wave = tid >> 6;
    unsigned char* ws = p.ws;
    {
        LAS float* scr = (LAS float*)(lds + wave * 8704);
        bf16_t* WTin = (bf16_t*)(ws + WS_WTIN); bf16_t* WTout = (bf16_t*)(ws + WS_WTOUT);
        const int gw = blockIdx.x * 8 + wave, NGW = gridDim.x * 8;
        constexpr int I_A = 16 * 80, I_B = 16 * 64, I_O = 16 * 32;
        for (int it = gw; it < I_A + I_B + I_O; it += NGW) {
            int r = it;
            if (r < I_A) { const int kb = r / 80, nb = r % 80; p0_transpose_item(p.w_in, DIN, DM, WTin, nb * 32, nb * 32, kb * 64, scr, lane); continue; } r -= I_A;
            if (r < I_B) { const int kb = r / 64, nb = r % 64; p0_transpose_item(p.w_in, DIN, DM, WTin, 2568 + nb * 32, 2560 + nb * 32, kb * 64, scr, lane); continue; } r -= I_B;
            { const int kb = r / 32, nb = r % 32; p0_transpose_item(p.w_out, DM, DM, WTout, nb * 32, nb * 32, kb * 64, scr, lane); }
        }
    }
}
__device__ __forceinline__ void phase0(const Params& p, LAS unsigned char* lds) {
    const int tid = threadIdx.x, lane = tid & 63, wave = tid >> 6;
    unsigned char* ws = p.ws;
    {
        float* wg = (float*)(ws + WS_WG);
        for (int i = blockIdx.x * 512 + tid; i < 16 * 1024; i += gridDim.x * 512) { const int j = i >> 10, k = i & 1023; const int col = (j < 8) ? 2560 + j : 4616 + (j - 8); wg[i] = p.w_in[(size_t)k * DIN + col]; }
    }
    __syncthreads();
    {
        float* mod = (float*)(ws + WS_MOD);
        LAS float* red = (LAS float*)lds;
        for (int cb = blockIdx.x; cb < 192; cb += gridDim.x) {
            const int cl = tid & 15, kp = tid >> 4, col = cb * 16 + cl;
            float a0 = 0.f, a1 = 0.f, a2 = 0.f, a3 = 0.f;
#pragma unroll 4
            for (int k = kp * 32; k < kp * 32 + 32; ++k) { const float w = p.w_ada[(size_t)k * 3072 + col];
                a0 += p.c[k] * w; a1 += p.c[1024 + k] * w; a2 += p.c[2048 + k] * w; a3 += p.c[3072 + k] * w; }
            red[(kp * 16 + cl) * 4 + 0] = a0; red[(kp * 16 + cl) * 4 + 1] = a1; red[(kp * 16 + cl) * 4 + 2] = a2; red[(kp * 16 + cl) * 4 + 3] = a3;
            __syncthreads();
            if (tid < 64) { const int c2 = tid & 15, b = tid >> 4; float s = 0.f;
                for (int k2 = 0; k2 < 32; ++k2) s += red[(k2 * 16 + c2) * 4 + b];
                mod[b * 3072 + cb * 16 + c2] = s + p.b_ada[cb * 16 + c2]; }
            __syncthreads();
        }
    }
}

__device__ __forceinline__ void phase1a(const Params& p, LAS unsigned char* lds) {
    const int tid = threadIdx.x, lane = tid & 63, wave = tid >> 6;
    unsigned char* ws = p.ws;
    const float* mod = (const float*)(ws + WS_MOD);
    const float* wgG = (const float*)(ws + WS_WG);
    p0_weights(p, lds);
    __syncthreads();
    LAS float* wg = (LAS float*)lds;
    for (int i = tid; i < 16 * 1024 / 4; i += 512) ((LAS f32x4*)wg)[i] = ((const f32x4*)wgG)[i];
    __syncthreads();
    bf16_t* H = (bf16_t*)(ws + WS_H); float* G = (float*)(ws + WS_GATES);
    const int NGW = gridDim.x * 8;
    for (int grp = blockIdx.x * 8 + wave; grp < T_ / 16; grp += NGW) {
        const int mb = grp * 16, b = mb >> 13;
        f32x4 A4[4], S4[4];
#pragma unroll
        for (int j = 0; j < 4; ++j) { const int c = 4 * (lane + 64 * j);
            const f32x4 g4 = *(const f32x4*)(p.norm_g + c), sh = *(const f32x4*)(mod + b * 3072 + c), sc = *(const f32x4*)(mod + b * 3072 + 1024 + c);
            A4[j] = g4 * (sc + 1.0f); S4[j] = sh; }
        f32x4 v[4], n[4];
        { const f32x4* x0 = (const f32x4*)(p.x + (size_t)mb * DM) + lane;
#pragma unroll
          for (int j = 0; j < 4; ++j) n[j] = x0[64 * j]; }
#pragma unroll 1
        for (int r = 0; r < 16; ++r) {
            const int m = mb + r;
#pragma unroll
            for (int j = 0; j < 4; ++j) v[j] = n[j];
            { const f32x4* xn = (const f32x4*)(p.x + (size_t)((r + 1 < 16) ? m + 1 : m) * DM) + lane;
#pragma unroll
                for (int j = 0; j < 4; ++j) n[j] = xn[64 * j]; }
            float ss = 0.f;
#pragma unroll
            for (int j = 0; j < 4; ++j) ss += (v[j].x * v[j].x + v[j].y * v[j].y) + (v[j].z * v[j].z + v[j].w * v[j].w);
            const float rstd = __builtin_amdgcn_rsqf(wave_sum(ss) * (1.f / DM) + EPS);
            float ga[16];
#pragma unroll
            for (int q = 0; q < 16; ++q) ga[q] = 0.f;
            unsigned long long* o8 = (unsigned long long*)(H + (size_t)m * DM) + lane;
#pragma unroll
            for (int j = 0; j < 4; ++j) {
                const int c = 4 * (lane + 64 * j);
                const f32x4 h4 = (v[j] * rstd) * A4[j] + S4[j];
                o8[64 * j] = (unsigned long long)cvt_pk_bf16(h4.x, h4.y) | ((unsigned long long)cvt_pk_bf16(h4.z, h4.w) << 32);
#pragma unroll
                for (int q = 0; q < 16; ++q) { const f32x4 w4 = *(const LAS f32x4*)(wg + q * 1024 + c); ga[q] += (h4.x * w4.x + h4.y * w4.y) + (h4.z * w4.z + h4.w * w4.w); }
            }
            float r8[8], r4[4], r2[2], r1;
            { const bool up = (lane & 32) != 0;
#pragma unroll
              for (int i = 0; i < 8; ++i) { const float keep = up ? ga[i + 8] : ga[i], send = up ? ga[i] : ga[i + 8]; r8[i] = keep + __shfl_xor(send, 32); } }
            { const bool up = (lane & 16) != 0;
#pragma unroll
              for (int i = 0; i < 4; ++i) { const float keep = up ? r8[i + 4] : r8[i], send = up ? r8[i] : r8[i + 4]; r4[i] = keep + __shfl_xor(send, 16); } }
            { const bool up = (lane & 8) != 0;
#pragma unroll
              for (int i = 0; i < 2; ++i) { const float keep = up ? r4[i + 2] : r4[i], send = up ? r4[i] : r4[i + 2]; r2[i] = keep + __shfl_xor(send, 8); } }
            { const bool up = (lane & 4) != 0; const float keep = up ? r2[1] : r2[0], send = up ? r2[0] : r2[1]; r1 = keep + __shfl_xor(send, 4); }
            r1 += __shfl_xor(r1, 2); r1 += __shfl_xor(r1, 1);
            if ((lane & 3) == 0) { const int idx = ((lane >> 5) & 1) * 8 + ((lane >> 4) & 1) * 4 + ((lane >> 3) & 1) * 2 + ((lane >> 2) & 1); G[(size_t)m * 16 + idx] = r1; }
        }
    }
}

__device__ __forceinline__ u32x4 conv8(const Params& p, const bf16_t* U, size_t m, int t, int c0, float mul) {
    float acc[8];
    { const f32x4 b0 = *(const f32x4*)(p.conv_b + c0), b1 = *(const f32x4*)(p.conv_b + c0 + 4);
      acc[0] = b0[0]; acc[1] = b0[1]; acc[2] = b0[2]; acc[3] = b0[3]; acc[4] = b1[0]; acc[5] = b1[1]; acc[6] = b1[2]; acc[7] = b1[3]; }
#pragma unroll
    for (int j = 0; j < 4; ++j) {
        if (t - 3 + j >= 0) {
            const u32x4 w = *(const u32x4*)(U + (m - 3 + j) * NU + c0);
            const f32x4 w0 = *(const f32x4*)(p.conv_w + j * 1024 + c0), w1 = *(const f32x4*)(p.conv_w + j * 1024 + c0 + 4);
            acc[0] += w0[0] * bflo(w.x); acc[1] += w0[1] * bfhi(w.x); acc[2] += w0[2] * bflo(w.y); acc[3] += w0[3] * bfhi(w.y);
            acc[4] += w1[0] * bflo(w.z); acc[5] += w1[1] * bfhi(w.z); acc[6] += w1[2] * bflo(w.w); acc[7] += w1[3] * bfhi(w.w);
        }
    }
#pragma unroll
    for (int i = 0; i < 8; ++i) acc[i] = silu_f(acc[i]) * mul;
    u32x4 o; o.x = cvt_pk_bf16(acc[0], acc[1]); o.y = cvt_pk_bf16(acc[2], acc[3]); o.z = cvt_pk_bf16(acc[4], acc[5]); o.w = cvt_pk_bf16(acc[6], acc[7]);
    return o;
}
constexpr float KSCALE = 0.08838834764831845f;

__device__ __forceinline__ float block_excl_scan_add(float v, LAS float* scr, int tid, float& total) {
    const int lane = tid & 63, wave = tid >> 6;
    float inc = v;
#pragma unroll
    for (int o = 1; o < 64; o <<= 1) { const float t = __shfl_up(inc, o); if (lane >= o) inc += t; }
    if (lane == 63) scr[wave] = inc;
    __syncthreads();
    float base = 0.f, tot = 0.f;
#pragma unroll
    for (int w = 0; w < 8; ++w) { const float s = scr[w]; if (w < wave) base += s; tot += s; }
    __syncthreads();
    total = tot;
    return base + inc - v;
}
__device__ __forceinline__ float block_excl_scan_max(float v, LAS float* scr, int tid) {
    const int lane = tid & 63, wave = tid >> 6;
    float inc = v;
#pragma unroll
    for (int o = 1; o < 64; o <<= 1) { const float t = __shfl_up(inc, o); if (lane >= o) inc = fmaxf(inc, t); }
    if (lane == 63) scr[wave] = inc;
    __syncthreads();
    float base = -INFINITY;
#pragma unroll
    for (int w = 0; w < 8; ++w) { const float s = scr[w]; if (w < wave) base = fmaxf(base, s); }
    __syncthreads();
    float ex = __shfl_up(inc, 1); if (lane == 0) ex = -INFINITY;
    return fmaxf(base, ex);
}

__device__ __forceinline__ void phase2a(const Params& p, LAS unsigned char* lds) {
    const int tid = threadIdx.x;
    unsigned char* ws = p.ws;
    const float* G = (const float*)(ws + WS_GATES);
    bf16_t* U = (bf16_t*)(ws + WS_U);
    LAS float* scr = (LAS float*)lds;
    for (int s = blockIdx.x; s < 48; s += gridDim.x) {
        const int t0 = tid * 16;
        if (s < 32) {
            const int b = s >> 3, h = s & 7; const float bias = p.b_ff[h];
            float lf[16]; float run = 0.f;
#pragma unroll
            for (int i = 0; i < 16; ++i) { run += logsigmoid_f(G[((size_t)b * SEQ + t0 + i) * 16 + 8 + h] + bias); lf[i] = run; }
            float tot; const float off = block_excl_scan_add(run, scr, tid, tot);
            float* F = (float*)(ws + WS_FF) + (size_t)s * SEQ + t0;
#pragma unroll
            for (int i = 0; i < 16; ++i) F[i] = off + lf[i];
        } else {
            const int bh = s - 32, b = bh >> 2, h = bh & 3; const float bf = p.b_fm[h], bi = p.b_ig[h];
            float Fc[16], ig[16]; float run = 0.f;
#pragma unroll
            for (int i = 0; i < 16; ++i) { const float* gr = G + ((size_t)b * SEQ + t0 + i) * 16; run += logsigmoid_f(gr[4 + h] + bf); Fc[i] = run; ig[i] = gr[h] + bi; }
            float tot; const float off = block_excl_scan_add(run, scr, tid, tot);
            float gg[16]; float mx = -INFINITY;
#pragma unroll
            for (int i = 0; i < 16; ++i) { Fc[i] += off; gg[i] = ig[i] - Fc[i]; mx = fmaxf(mx, gg[i]); }
            float gr_run = fmaxf(0.f, block_excl_scan_max(mx, scr, tid));
            float* MG = (float*)(ws + WS_MG) + (size_t)bh * SEQ + t0; float* MGR = (float*)(ws + WS_MGR) + (size_t)bh * SEQ + t0; float* MFL = (float*)(ws + WS_MFL) + (size_t)bh * SEQ + t0;
#pragma unroll
            for (int i = 0; i < 16; ++i) { gr_run = fmaxf(gr_run, gg[i]); MG[i] = gg[i]; MGR[i] = gr_run; MFL[i] = __expf(-Fc[i] - gr_run); }
        }
    }
    if (blockIdx.x >= 48 || gridDim.x <= 48) {
        bf16_t* QC = (bf16_t*)(ws + WS_QC); bf16_t* KC = (bf16_t*)(ws + WS_KC);
        const int nb = (gridDim.x > 48) ? (int)gridDim.x - 48 : (int)gridDim.x, b0 = (gridDim.x > 48) ? (int)blockIdx.x - 48 : (int)blockIdx.x;
        const int ch = tid & 127, c0 = ch * 8;
        const float mul = (ch < 64) ? 1.0f : KSCALE;
        float wt[4][8], bs[8];
#pragma unroll
        for (int i = 0; i < 8; ++i) { bs[i] = p.conv_b[c0 + i];
#pragma unroll
            for (int jt = 0; jt < 4; ++jt) wt[jt][i] = p.conv_w[jt * 1024 + c0 + i]; }
        bf16_t* dstb = (ch < 64) ? (QC + c0) : (KC + (c0 - 512));
#pragma unroll 1
        for (int run = b0 * 4 + (tid >> 7); run < T_ / 8; run += nb * 4) {
            const size_t mb = (size_t)run * 8; const int tb = (int)(mb & (SEQ - 1));
            u32x4 r[11];
#pragma unroll
            for (int i = 0; i < 11; ++i) { if (tb - 3 + i >= 0) r[i] = *(const u32x4*)(U + (mb - 3 + i) * NU + c0); else r[i] = (u32x4){0u, 0u, 0u, 0u}; }
#pragma unroll
            for (int o = 0; o < 8; ++o) {
                float acc[8];
#pragma unroll
                for (int i = 0; i < 8; ++i) acc[i] = bs[i];
#pragma unroll
                for (int jt = 0; jt < 4; ++jt) { const u32x4 w = r[o + jt];
                    acc[0] += wt[jt][0] * bflo(w.x); acc[1] += wt[jt][1] * bfhi(w.x); acc[2] += wt[jt][2] * bflo(w.y); acc[3] += wt[jt][3] * bfhi(w.y);
                    acc[4] += wt[jt][4] * bflo(w.z); acc[5] += wt[jt][5] * bfhi(w.z); acc[6] += wt[jt][6] * bflo(w.w); acc[7] += wt[jt][7] * bfhi(w.w); }
#pragma unroll
                for (int i = 0; i < 8; ++i) acc[i] = silu_f(acc[i]) * mul;
                u32x4 ov; ov.x = cvt_pk_bf16(acc[0], acc[1]); ov.y = cvt_pk_bf16(acc[2], acc[3]); ov.z = cvt_pk_bf16(acc[4], acc[5]); ov.w = cvt_pk_bf16(acc[6], acc[7]);
                *(u32x4*)(dstb + (mb + o) * 512) = ov;
            }
        }
        {
            const size_t NIT = (size_t)T_ * 64;
            const float* gkp = p.gk + (tid & 7) * 8;
            const f32x4 g0 = *(const f32x4*)gkp, g1 = *(const f32x4*)(gkp + 4);
            bf16_t* Uw = (bf16_t*)(ws + WS_U);
#pragma unroll 1
            for (size_t it = (size_t)b0 * 512 + tid; it < NIT; it += (size_t)nb * 512 * 8) {
                u32x4 w[8];
#pragma unroll
                for (int u = 0; u < 8; ++u) { const size_t i2 = it + (size_t)u * nb * 512; const size_t i3 = (i2 < NIT) ? i2 : it; w[u] = *(const u32x4*)(Uw + (i3 >> 6) * NU + UC_FK + (int)(i3 & 63) * 8); }
#pragma unroll
                for (int u = 0; u < 8; ++u) {
                    const size_t i2 = it + (size_t)u * nb * 512;
                    float ss = (bflo(w[u].x) * bflo(w[u].x) + bfhi(w[u].x) * bfhi(w[u].x)) + (bflo(w[u].y) * bflo(w[u].y) + bfhi(w[u].y) * bfhi(w[u].y))
                             + (bflo(w[u].z) * bflo(w[u].z) + bfhi(w[u].z) * bfhi(w[u].z)) + (bflo(w[u].w) * bflo(w[u].w) + bfhi(w[u].w) * bfhi(w[u].w));
                    ss += __shfl_xor(ss, 1); ss += __shfl_xor(ss, 2); ss += __shfl_xor(ss, 4);
                    const float r = __builtin_amdgcn_rsqf(ss * (1.f / 64.f) + EPS);
                    u32x4 o; o.x = cvt_pk_bf16(bflo(w[u].x) * r * g0[0], bfhi(w[u].x) * r * g0[1]); o.y = cvt_pk_bf16(bflo(w[u].y) * r * g0[2], bfhi(w[u].y) * r * g0[3]);
                    o.z = cvt_pk_bf16(bflo(w[u].z) * r * g1[0], bfhi(w[u].z) * r * g1[1]); o.w = cvt_pk_bf16(bflo(w[u].w) * r * g1[2], bfhi(w[u].w) * r * g1[3]);
                    if (i2 < NIT) *(u32x4*)(Uw + (i2 >> 6) * NU + UC_FK + (int)(i2 & 63) * 8) = o;
                }
            }
        }
    }
}

constexpr int PQ = 272, PV = 304, PP = 144;
constexpr int L_Q = 0, L_K = 17408, L_V = 34816, L_C = 54272, L_P = 93440;

__device__ __forceinline__ void mlstm_a_phase(const Params& p, LAS unsigned char* lds, int first, int stride) {
    const int tid = threadIdx.x, lane = tid & 63, wid = tid >> 6;
    unsigned char* ws = p.ws;
    const bf16_t* KC = (const bf16_t*)(ws + WS_KC);
    const bf16_t* U = (const bf16_t*)(ws + WS_U);
    const int row0 = tid >> 4, ch = tid & 15;
    u32x4 rk[2], rv[2]; float rg[2], rge = 0.f;
#define A_LOAD(unit_) do { const int bh_ = (unit_) >> 7, j_ = (unit_) & 127, b_ = bh_ >> 2, h_ = bh_ & 3; const size_t m0_ = (size_t)b_ * SEQ + j_ * 64; \
        const float* MG_ = (const float*)(ws + WS_MG) + (size_t)bh_ * SEQ + j_ * 64; \
        rge = ((const float*)(ws + WS_MGR))[(size_t)bh_ * SEQ + j_ * 64 + 63]; \
        _Pragma("unroll") for (int i = 0; i < 2; ++i) { const int row = row0 + 32 * i; rg[i] = MG_[row]; \
            rk[i] = *(const u32x4*)(KC + (m0_ + row) * 512 + h_ * 128 + ch * 8); rv[i] = *(const u32x4*)(U + (m0_ + row) * NU + UC_MV + h_ * 128 + ch * 8); } } while (0)
    int unit = first;
    if (unit >= 2048) return;
    A_LOAD(unit);
    if (tid < 128) { const int row = tid >> 1, c2 = 16 + (tid & 1); u32x4 o = {0u, 0u, 0u, 0u}; if (c2 == 16) o.x = 0x3F80u; *(LAS u32x4*)(lds + L_V + row * PV + c2 * 16) = o; }
#pragma unroll 1
    for (; unit < 2048; unit += stride) {
#pragma unroll
        for (int i = 0; i < 2; ++i) { const int row = row0 + 32 * i; const float sc = __expf(rg[i] - rge); const u32x4 w = rk[i];
            u32x4 o; o.x = cvt_pk_bf16(bflo(w.x) * sc, bfhi(w.x) * sc); o.y = cvt_pk_bf16(bflo(w.y) * sc, bfhi(w.y) * sc); o.z = cvt_pk_bf16(bflo(w.z) * sc, bfhi(w.z) * sc); o.w = cvt_pk_bf16(bflo(w.w) * sc, bfhi(w.w) * sc);
            *(LAS u32x4*)(lds + L_K + row * PQ + ch * 16) = o;
            *(LAS u32x4*)(lds + L_V + row * PV + ch * 16) = rv[i]; }
        LDS_BARRIER();
        if (unit + stride < 2048) A_LOAD(unit + stride);
        {
            const int g = lane >> 4, q = (lane & 15) >> 2, pp = lane & 3, fr = lane & 15;
            const int d0 = 16 * wid;
            bf16x8 af[2];
#pragma unroll
            for (int kk = 0; kk < 2; ++kk) {
                const LAS unsigned char* a0 = lds + L_K + (32 * kk + 8 * g + q) * PQ + (d0 + 4 * pp) * 2;
                af[kk] = cat8(tr16(a0), tr16(a0 + 4 * PQ));
            }
            bf16_t* dst = (bf16_t*)(ws + WS_CST) + (size_t)unit * CST_ELEMS;
#pragma unroll
            for (int et = 0; et < 9; ++et) {
                f32x4 acc = {0.f, 0.f, 0.f, 0.f};
#pragma unroll
                for (int kk = 0; kk < 2; ++kk) {
                    const LAS unsigned char* b0 = lds + L_V + (32 * kk + 8 * g + q) * PV + (16 * et + 4 * pp) * 2;
                    const bf16x8 bfv = cat8(tr16(b0), tr16(b0 + 4 * PV));
                    acc = __builtin_amdgcn_mfma_f32_16x16x32_bf16(af[kk], bfv, acc, 0, 0, 0);
                }
                u32x2 o; o.x = cvt_pk_bf16_c(acc[0], acc[1]); o.y = cvt_pk_bf16_c(acc[2], acc[3]);
                *(LAS u32x2*)(lds + L_C + (16 * et + fr) * PQ + (d0 + 4 * g) * 2) = o;
            }
            LDS_BARRIER();
#pragma unroll
            for (int i = 0; i < 5; ++i) { const int item = tid + 512 * i; if (item < CE * 16) *(u32x4*)(dst + (item >> 4) * 128 + (item & 15) * 8) = *(const LAS u32x4*)(lds + L_C + (item >> 4) * PQ + (item & 15) * 16); }
        }
        LDS_BARRIER();
    }
#undef A_LOAD
}

constexpr int SCAN_ITEMS = 16 * (CST_ELEMS / 2) / 512;
__device__ __forceinline__ void mlstm_scan(const Params& p, int blk) {
    unsigned char* ws = p.ws;
    const int gid = blk * 512 + threadIdx.x;
    const int bh = gid / (CST_ELEMS / 2), el = (gid % (CST_ELEMS / 2)) * 2;
    bf16_t* base = (bf16_t*)(ws + WS_CST) + (size_t)bh * 128 * CST_ELEMS + el;
    const float* MGR = (const float*)(ws + WS_MGR) + (size_t)bh * SEQ;
    float c0 = 0.f, c1 = 0.f; float gprev = 0.f;
#pragma unroll 1
    for (int j0 = 0; j0 < 128; j0 += 32) {
        unsigned d[32]; float ge[32];
#pragma unroll
        for (int i = 0; i < 32; ++i) { d[i] = *(const unsigned*)(base + (size_t)(j0 + i) * CST_ELEMS); ge[i] = MGR[(j0 + i) * 64 + 63]; }
#pragma unroll
        for (int i = 0; i < 32; ++i) {
            *(unsigned*)(base + (size_t)(j0 + i) * CST_ELEMS) = cvt_pk_bf16(c0, c1);
            const float dec = __expf(gprev - ge[i]); gprev = ge[i];
            c0 = dec * c0 + bflo(d[i]); c1 = dec * c1 + bfhi(d[i]);
        }
    }
}

__device__ __forceinline__ void mlstm_c_phase(const Params& p, LAS unsigned char* lds, int first, unsigned* qctr, LAS int* qslot, int cbase) {
    const int tid = threadIdx.x, lane = tid & 63, wid = tid >> 6;
    unsigned char* ws = p.ws;
    const bf16_t* U = (const bf16_t*)(ws + WS_U);
    const bf16_t* QC = (const bf16_t*)(ws + WS_QC); const bf16_t* KC = (const bf16_t*)(ws + WS_KC);
    const int row0 = tid >> 4, ch = tid & 15;
    const int fr = lane & 15, fq = lane >> 4;
    u32x4 rq[2], rk[2], rv[2], rc[5];
#define C_LOAD(unit_) do { const int bh_ = (unit_) >> 7, j_ = (unit_) & 127, b_ = bh_ >> 2, h_ = bh_ & 3; const size_t m0_ = (size_t)b_ * SEQ + j_ * 64; \
        const bf16_t* CS_ = (const bf16_t*)(ws + WS_CST) + (size_t)(unit_) * CST_ELEMS; \
        _Pragma("unroll") for (int i = 0; i < 2; ++i) { const int row = row0 + 32 * i; \
            rq[i] = *(const u32x4*)(QC + (m0_ + row) * 512 + h_ * 128 + ch * 8); rk[i] = *(const u32x4*)(KC + (m0_ + row) * 512 + h_ * 128 + ch * 8); \
            rv[i] = *(const u32x4*)(U + (m0_ + row) * NU + UC_MV + h_ * 128 + ch * 8); } \
        _Pragma("unroll") for (int i = 0; i < 5; ++i) { const int item = tid + 512 * i; if (item < CE * 16) rc[i] = *(const u32x4*)(CS_ + (item >> 4) * 128 + (item & 15) * 8); } } while (0)
    int unit = first;
    if (unit >= 2048) return;
    C_LOAD(unit);
    if (tid < 128) { const int row = tid >> 1, c2 = 16 + (tid & 1); u32x4 o = {0u, 0u, 0u, 0u}; if (c2 == 16) o.x = 0x3F80u; *(LAS u32x4*)(lds + L_V + row * PV + c2 * 16) = o; }
#pragma unroll 1
    for (; unit < 2048; ) {
        const int bh = unit >> 7, j = unit & 127, b = bh >> 2, h = bh & 3;
        const size_t m0 = (size_t)b * SEQ + j * 64;
        const float* MG = (const float*)(ws + WS_MG) + (size_t)bh * SEQ + j * 64;
        const float* MGR = (const float*)(ws + WS_MGR) + (size_t)bh * SEQ + j * 64;
        const float* MFL = (const float*)(ws + WS_MFL) + (size_t)bh * SEQ + j * 64;
#pragma unroll
        for (int i = 0; i < 2; ++i) { const int row = row0 + 32 * i;
            *(LAS u32x4*)(lds + L_Q + row * PQ + ch * 16) = rq[i]; *(LAS u32x4*)(lds + L_K + row * PQ + ch * 16) = rk[i]; *(LAS u32x4*)(lds + L_V + row * PV + ch * 16) = rv[i]; }
#pragma unroll
        for (int i = 0; i < 5; ++i) { const int item = tid + 512 * i; if (item < CE * 16) *(LAS u32x4*)(lds + L_C + (item >> 4) * PQ + (item & 15) * 16) = rc[i]; }
        if (tid == 0) *qslot = (int)__hip_atomic_fetch_add(qctr, 1u, __ATOMIC_RELAXED, __HIP_MEMORY_SCOPE_AGENT);
        LDS_BARRIER();
        const int nxt = *qslot - cbase;
        const int t0a = 16 * (wid & 3);
        const float Gt = MGR[t0a + fr];
        const f32x4 g4a = *(const f32x4*)(MG + 16 * ((wid >> 2) * 2) + 4 * fq), g4b = *(const f32x4*)(MG + 16 * ((wid >> 2) * 2 + 1) + 4 * fq);
        const float Gprev_raw = MGR[(j == 0) ? 0 : -1];
        const float flr = MFL[t0a + fr];
        const size_t m = m0 + t0a + fr;
        u32x2 ow[8], zw[8];
        if (wid < 4) {
#pragma unroll
            for (int et = 0; et < 8; ++et) { const int e = 16 * et + 4 * fq; ow[et] = *(const u32x2*)(U + m * NU + UC_MO + h * 128 + e); zw[et] = *(const u32x2*)(U + m * NU + UC_MZ + h * 128 + e); }
        }
        __builtin_amdgcn_sched_barrier(0);
        { const int nl = (nxt < 2048) ? nxt : 2047; C_LOAD(nl); }
        __builtin_amdgcn_sched_barrier(0);
        {
            const int t0 = t0a;
#pragma unroll
            for (int si = 0; si < 2; ++si) {
                const int s0 = 16 * ((wid >> 2) * 2 + si);
                f32x4 acc = {0.f, 0.f, 0.f, 0.f};
#pragma unroll
                for (int kk = 0; kk < 4; ++kk) {
                    const bf16x8 ka = *(const LAS bf16x8*)(lds + L_K + (s0 + fr) * PQ + (32 * kk + 8 * fq) * 2);
                    const bf16x8 qb = *(const LAS bf16x8*)(lds + L_Q + (t0 + fr) * PQ + (32 * kk + 8 * fq) * 2);
                    acc = __builtin_amdgcn_mfma_f32_16x16x32_bf16(ka, qb, acc, 0, 0, 0);
                }
                const f32x4 g4 = si ? g4b : g4a;
                float pv[4];
#pragma unroll
                for (int jj = 0; jj < 4; ++jj) { const int s_ = s0 + 4 * fq + jj; pv[jj] = (s_ <= t0 + fr) ? acc[jj] * __expf(g4[jj] - Gt) : 0.f; }
                u32x2 o; o.x = cvt_pk_bf16(pv[0], pv[1]); o.y = cvt_pk_bf16(pv[2], pv[3]);
                *(LAS u32x2*)(lds + L_P + (t0 + fr) * PP + (s0 + 4 * fq) * 2) = o;
            }
        }
        LDS_BARRIER();
        if (wid < 4) {
            const int t0 = 16 * wid;
            const int g = fq, q = (lane & 15) >> 2, pp = lane & 3;
            f32x4 acc[9];
#pragma unroll
            for (int et = 0; et < 9; ++et) acc[et] = (f32x4){0.f, 0.f, 0.f, 0.f};
#pragma unroll
            for (int kk = 0; kk < 4; ++kk) {
                const bf16x8 qb = *(const LAS bf16x8*)(lds + L_Q + (t0 + fr) * PQ + (32 * kk + 8 * fq) * 2);
#pragma unroll
                for (int et = 0; et < 9; ++et) {
                    const bf16x8 ca = *(const LAS bf16x8*)(lds + L_C + (16 * et + fr) * PQ + (32 * kk + 8 * fq) * 2);
                    acc[et] = __builtin_amdgcn_mfma_f32_16x16x32_bf16(ca, qb, acc[et], 0, 0, 0);
                }
            }
            const float Gprev = (j == 0) ? 0.f : Gprev_raw;
            const float wi = __expf(Gprev - Gt);
#pragma unroll
            for (int et = 0; et < 9; ++et) acc[et] = acc[et] * wi;
#pragma unroll
            for (int kk = 0; kk < 2; ++kk) {
                const bf16x8 pb = *(const LAS bf16x8*)(lds + L_P + (t0 + fr) * PP + (32 * kk + 8 * fq) * 2);
#pragma unroll
                for (int et = 0; et < 9; ++et) {
                    const LAS unsigned char* a0 = lds + L_V + (32 * kk + 8 * g + q) * PV + (16 * et + 4 * pp) * 2;
                    const bf16x8 va = cat8(tr16(a0), tr16(a0 + 4 * PV));
                    acc[et] = __builtin_amdgcn_mfma_f32_16x16x32_bf16(va, pb, acc[et], 0, 0, 0);
                }
            }
            const float den = __shfl(acc[8][0], fr);
            const float inv = __builtin_amdgcn_rcpf(fmaxf(fabsf(den), flr));
            float hm[8][4]; float s1 = 0.f;
#pragma unroll
            for (int et = 0; et < 8; ++et) {
                hm[et][0] = sigmoid_f(bflo(ow[et].x)) * (acc[et][0] * inv); hm[et][1] = sigmoid_f(bfhi(ow[et].x)) * (acc[et][1] * inv);
                hm[et][2] = sigmoid_f(bflo(ow[et].y)) * (acc[et][2] * inv); hm[et][3] = sigmoid_f(bfhi(ow[et].y)) * (acc[et][3] * inv);
                s1 += (hm[et][0] + hm[et][1]) + (hm[et][2] + hm[et][3]);
            }
            s1 += __shfl_xor(s1, 16); s1 += __shfl_xor(s1, 32);
            const float mu = s1 * (1.f / 128.f); float s2 = 0.f;
#pragma unroll
            for (int et = 0; et < 8; ++et)
#pragma unroll
                for (int jj = 0; jj < 4; ++jj) { hm[et][jj] -= mu; s2 += hm[et][jj] * hm[et][jj]; }
            s2 += __shfl_xor(s2, 16); s2 += __shfl_xor(s2, 32);
            const float rstd = __builtin_amdgcn_rsqf(s2 * (1.f / 128.f) + EPS);
            bf16_t* Y = (bf16_t*)(ws + WS_Y);
#pragma unroll
            for (int et = 0; et < 8; ++et) {
                const int e = 16 * et + 4 * fq;
                const f32x4 gn = *(const LAS f32x4*)(lds + 131072 + 512 + (h * 128 + e) * 4);
                const float y0 = hm[et][0] * rstd * gn[0] * silu_f(bflo(zw[et].x)), y1 = hm[et][1] * rstd * gn[1] * silu_f(bfhi(zw[et].x));
                const float y2 = hm[et][2] * rstd * gn[2] * silu_f(bflo(zw[et].y)), y3 = hm[et][3] * rstd * gn[3] * silu_f(bfhi(zw[et].y));
                u32x2 o; o.x = cvt_pk_bf16(y0, y1); o.y = cvt_pk_bf16(y2, y3);
                *(u32x2*)(Y + m * DM + h * 128 + e) = o;
            }
        }
        LDS_BARRIER();
        unit = nxt;
    }
#undef C_LOAD
}

constexpr int FK_P = 144;
constexpr int FL_K = 0, FL_V = 36864, FL_B = 73728;
__device__ __forceinline__ void fox_unit(const Params& p, LAS unsigned char* lds, int bh, int qb, float THR) {
    const int tid = threadIdx.x, lane = tid & 63, wid = tid >> 6, r32 = lane & 31, hi = lane >> 5;
    unsigned char* ws = p.ws;
    const int b = bh >> 3, h = bh & 7;
    const size_t rowbase = (size_t)b * SEQ; const int q0 = qb * 256;
    const bf16_t* U = (const bf16_t*)(ws + WS_U);
    const float* F = (const float*)(ws + WS_FF) + (size_t)bh * SEQ;
    const int NT = 4 * qb + 4;
    const float Fref = F[q0];
    const bf16_t* Qrow = U + (rowbase + q0 + wid * 32 + r32) * NU + UC_FQ + h * 64;
    u32x4 qw[4];
#pragma unroll
    for (int d0 = 0; d0 < 4; ++d0) qw[d0] = *(const u32x4*)(Qrow + d0 * 16 + hi * 8);
    const int srow = tid >> 3, sch = tid & 7;
    const bf16_t* Kg = U + (rowbase + srow) * NU + UC_FK + h * 64 + sch * 8;
    const bf16_t* Vg = Kg + 512;
#define FOX_GLOAD(KR, VR, BR, t) do { KR = *(const u32x4*)(Kg + (size_t)(t) * 64 * NU); VR = *(const u32x4*)(Vg + (size_t)(t) * 64 * NU); BR = F[(t) * 64 + srow]; } while (0)
    u32x4 kA, vA, kB, vB; float bA = 0.f, bB = 0.f;
    FOX_GLOAD(kA, vA, bA, NT - 1);
    FOX_GLOAD(kB, vB, bB, NT - 2);
    int j0;
    {
        LAS int* sj = (LAS int*)(lds + FL_B + 1024);
        if (tid < 128) {
            const bool live = (tid < NT - 4) && (Fref - F[64 * tid + 63] >= -THR);
            const unsigned long long mk = __ballot(live);
            if (lane == 0) sj[wid] = mk ? (__ffsll((long long)mk) - 1 + 64 * wid) : (NT - 4);
        }
        __syncthreads();
        j0 = min(min(sj[0], sj[1]), NT - 4) & ~1;
    }
    bf16x8 qr[4];
    {
        float ss = 0.f;
#pragma unroll
        for (int d0 = 0; d0 < 4; ++d0) {
            ss += (bflo(qw[d0].x) * bflo(qw[d0].x) + bfhi(qw[d0].x) * bfhi(qw[d0].x)) + (bflo(qw[d0].y) * bflo(qw[d0].y) + bfhi(qw[d0].y) * bfhi(qw[d0].y))
                + (bflo(qw[d0].z) * bflo(qw[d0].z) + bfhi(qw[d0].z) * bfhi(qw[d0].z)) + (bflo(qw[d0].w) * bflo(qw[d0].w) + bfhi(qw[d0].w) * bfhi(qw[d0].w)); }
        ss += __shfl_xor(ss, 32);
        const float r = C2 * __builtin_amdgcn_rsqf(ss * (1.f / 64.f) + EPS);
#pragma unroll
        for (int d0 = 0; d0 < 4; ++d0) { const f32x4 g0 = *(const LAS f32x4*)(lds + 131072 + 256 + (d0 * 16 + hi * 8) * 4), g1 = *(const LAS f32x4*)(lds + 131072 + 256 + (d0 * 16 + hi * 8 + 4) * 4);
            u32x4 o; o.x = cvt_pk_bf16(bflo(qw[d0].x) * r * g0[0], bfhi(qw[d0].x) * r * g0[1]); o.y = cvt_pk_bf16(bflo(qw[d0].y) * r * g0[2], bfhi(qw[d0].y) * r * g0[3]);
            o.z = cvt_pk_bf16(bflo(qw[d0].z) * r * g1[0], bfhi(qw[d0].z) * r * g1[1]); o.w = cvt_pk_bf16(bflo(qw[d0].w) * r * g1[2], bfhi(qw[d0].w) * r * g1[3]);
            qr[d0] = __builtin_bit_cast(bf16x8, o); }
    }
#define FOX_LSTORE(KR, VR, BR, buf) do { *(LAS u32x4*)(lds + FL_K + (buf) * 9216 + srow * FK_P + sch * 16) = KR; *(LAS u32x4*)(lds + FL_V + (buf) * 9216 + srow * FK_P + sch * 16) = VR; \
        if (sch == 0) *(LAS float*)(lds + FL_B + (buf) * 256 + srow * 4) = (Fref - BR) * LOG2E; } while (0)
    float m_run = -1.0e30f, l_run = 0.f;
    f32x16 o0, o1;
#pragma unroll
    for (int r = 0; r < 16; ++r) { o0[r] = 0.f; o1[r] = 0.f; }
    const int blk = (lane >> 4) & 1, q4 = (lane & 15) >> 2, pp = lane & 3;
#define FOX_COMPUTE(t, cur) do { if ((t) >= NT - 4 && 64 * ((t) - (NT - 4)) > 32 * wid + 31) break;     \
        const LAS unsigned char* Kt = lds + FL_K + (cur) * 9216; const LAS unsigned char* Vt = lds + FL_V + (cur) * 9216; const LAS float* Bt = (const LAS float*)(lds + FL_B + (cur) * 256); \
        f32x16 p0, p1; \
        _Pragma("unroll") for (int i = 0; i < 4; ++i) { const f32x4 b0 = *(const LAS f32x4*)(Bt + 8 * i + 4 * hi), b1 = *(const LAS f32x4*)(Bt + 32 + 8 * i + 4 * hi); \
            _Pragma("unroll") for (int e = 0; e < 4; ++e) { p0[4 * i + e] = b0[e]; p1[4 * i + e] = b1[e]; } } \
        _Pragma("unroll") for (int d0 = 0; d0 < 4; ++d0) { \
            const bf16x8 ka = *(const LAS bf16x8*)(Kt + r32 * FK_P + (d0 * 16 + hi * 8) * 2); \
            const bf16x8 kb = *(const LAS bf16x8*)(Kt + (r32 + 32) * FK_P + (d0 * 16 + hi * 8) * 2); \
            p0 = __builtin_amdgcn_mfma_f32_32x32x16_bf16(ka, qr[d0], p0, 0, 0, 0); \
            p1 = __builtin_amdgcn_mfma_f32_32x32x16_bf16(kb, qr[d0], p1, 0, 0, 0); } \
        if ((t) >= NT - 4 && 64 * ((t) - (NT - 4)) + 63 > 32 * wid) {     \
            const int qg = wid * 32 + r32; const int kb0 = ((t) - (NT - 4)) * 64 + 4 * hi; \
            _Pragma("unroll") for (int r = 0; r < 16; ++r) { const int kv = kb0 + (r & 3) + 8 * (r >> 2); if (kv > qg) p0[r] = -INFINITY; if (kv + 32 > qg) p1[r] = -INFINITY; } } \
        float mxa = __builtin_fmaxf(__builtin_fmaxf(p0[0], p0[1]), p1[0]), mxb = __builtin_fmaxf(__builtin_fmaxf(p0[2], p0[3]), p1[1]); mxa = __builtin_fmaxf(__builtin_fmaxf(mxa, p1[2]), p1[3]); \
        _Pragma("unroll") for (int r = 4; r < 16; r += 4) { mxa = __builtin_fmaxf(__builtin_fmaxf(mxa, p0[r]), p0[r + 1]); mxb = __builtin_fmaxf(__builtin_fmaxf(mxb, p0[r + 2]), p0[r + 3]); \
            mxa = __builtin_fmaxf(__builtin_fmaxf(mxa, p1[r]), p1[r + 1]); mxb = __builtin_fmaxf(__builtin_fmaxf(mxb, p1[r + 2]), p1[r + 3]); } \
        float mx = __builtin_fmaxf(mxa, mxb); \
        mx = fmaxf(mx, __shfl_xor(mx, 32)); \
        if (__any(mx > m_run)) {     \
            const float m_new = fmaxf(m_run, mx); const float alpha = __builtin_amdgcn_exp2f(m_run - m_new); m_run = m_new; l_run *= alpha; \
            _Pragma("unroll") for (int r = 0; r < 16; ++r) { o0[r] *= alpha; o1[r] *= alpha; } } \
        p0 = p0 - m_run; p1 = p1 - m_run;     \
        _Pragma("unroll") for (int r = 0; r < 16; ++r) { p0[r] = __builtin_amdgcn_exp2f(p0[r]); p1[r] = __builtin_amdgcn_exp2f(p1[r]); } \
        { const f32x16 sv = p0 + p1; const f32x4 s4 = (f32x4){sv[0], sv[1], sv[2], sv[3]} + (f32x4){sv[4], sv[5], sv[6], sv[7]} + (f32x4){sv[8], sv[9], sv[10], sv[11]} + (f32x4){sv[12], sv[13], sv[14], sv[15]}; \
          l_run += (s4[0] + s4[1]) + (s4[2] + s4[3]); } \
        u32x4 pw[4]; \
        _Pragma("unroll") for (int i = 0; i < 4; ++i) { pw[0][i] = cvt_pk_bf16_c(p0[2 * i], p0[2 * i + 1]); pw[1][i] = cvt_pk_bf16_c(p0[8 + 2 * i], p0[8 + 2 * i + 1]);     \
                                      pw[2][i] = cvt_pk_bf16_c(p1[2 * i], p1[2 * i + 1]); pw[3][i] = cvt_pk_bf16_c(p1[8 + 2 * i], p1[8 + 2 * i + 1]); } \
        _Pragma("unroll") for (int ks = 0; ks < 4; ++ks) { \
            const bf16x8 pb = __builtin_bit_cast(bf16x8, pw[ks]); \
            const LAS unsigned char* v0 = Vt + (16 * ks + 4 * hi + q4) * FK_P + (16 * blk + 4 * pp) * 2; \
            const bf16x8 va0 = cat8(tr16(v0), tr16(v0 + 8 * FK_P)); \
            const bf16x8 va1 = cat8(tr16(v0 + 64), tr16(v0 + 8 * FK_P + 64)); \
            o0 = __builtin_amdgcn_mfma_f32_32x32x16_bf16(va0, pb, o0, 0, 0, 0); \
            o1 = __builtin_amdgcn_mfma_f32_32x32x16_bf16(va1, pb, o1, 0, 0, 0); } \
    } while (0)
    const float B2 = (THR - 16.f) * 0.5f * LOG2E, M2 = 16.f * LOG2E;
    LAS int* stopit = (LAS int*)(lds + FL_B + 1280);
    if (tid < 8) stopit[tid] = 0x7fffffff;
    bool wdone = false;
    FOX_LSTORE(kA, vA, bA, 0);
    FOX_LSTORE(kB, vB, bB, 1);
    __syncthreads();
#pragma unroll 1
    for (int t = NT - 1; t > j0; t -= 2) {
        const int step = (NT - 1 - t) >> 1, set = step & 1;
        const bool more = t - 2 > j0;
        float fnx = 0.f;
        if (more) { FOX_GLOAD(kA, vA, bA, t - 2); FOX_GLOAD(kB, vB, bB, t - 3); fnx = F[64 * (t - 2) + 63]; }
        const int c0 = set * 2, n0 = 2 - c0;
        if (!wdone) { FOX_COMPUTE(t, c0); FOX_COMPUTE(t - 1, c0 + 1); }
        if (more) { FOX_LSTORE(kA, vA, bA, n0); FOX_LSTORE(kB, vB, bB, n0 + 1); }
        if (more && !wdone && t < NT - 2) {
            float mm = m_run;
#pragma unroll
            for (int o = 1; o < 64; o <<= 1) mm = fminf(mm, __shfl_xor(mm, o));
            if ((Fref - fnx) * LOG2E + B2 < mm - M2) { wdone = true; if (lane == 0) stopit[wid] = step; }
        }
        LDS_BARRIER();
        { const u32x4 s0 = *(const LAS u32x4*)stopit, s1 = *(const LAS u32x4*)(stopit + 4);
          if (max(max(max(s0.x, s0.y), max(s0.z, s0.w)), max(max(s1.x, s1.y), max(s1.z, s1.w))) <= (unsigned)step) break; }
    }
#undef FOX_GLOAD
#undef FOX_LSTORE
#undef FOX_COMPUTE
    l_run += __shfl_xor(l_run, 32);
    const float inv = __builtin_amdgcn_rcpf(l_run);
    const size_t m = rowbase + q0 + wid * 32 + r32;
    bf16_t* Y = (bf16_t*)(ws + WS_Y);
#pragma unroll
    for (int dh = 0; dh < 2; ++dh)
#pragma unroll
        for (int i = 0; i < 4; ++i) {
            const int d = dh * 32 + 8 * i + 4 * hi;
            const u32x2 zw = *(const u32x2*)(U + m * NU + UC_FZ + h * 64 + d);
            const float a0 = (dh ? o1[4 * i + 0] : o0[4 * i + 0]) * inv, a1 = (dh ? o1[4 * i + 1] : o0[4 * i + 1]) * inv, a2 = (dh ? o1[4 * i + 2] : o0[4 * i + 2]) * inv, a3 = (dh ? o1[4 * i + 3] : o0[4 * i + 3]) * inv;
            u32x2 o; o.x = cvt_pk_bf16(a0 * silu_f(bflo(zw.x)), a1 * silu_f(bfhi(zw.x))); o.y = cvt_pk_bf16(a2 * silu_f(bflo(zw.y)), a3 * silu_f(bfhi(zw.y)));
            *(u32x2*)(Y + m * DM + 512 + h * 64 + d) = o;
        }
}

#define XB_TMO      128
#define XB_XCNT(j)  (256  + 64 * (j))
#define XB_XSUB(j)  (1280 + 64 * (j))
#define XB_XGEN(j)  (2304 + 64 * (j))
#define XB_TOP      3328
#define XB_TOPGEN   3392
#define XCD_BAR_WORDS 3456
#define XB_SPIN_CAP (1u << 22)
__device__ __forceinline__ unsigned xb_ld(unsigned* p)              { return __hip_atomic_load(p, __ATOMIC_RELAXED, __HIP_MEMORY_SCOPE_AGENT); }
__device__ __forceinline__ unsigned xb_add(unsigned* p, unsigned v) { return __hip_atomic_fetch_add(p, v, __ATOMIC_RELAXED, __HIP_MEMORY_SCOPE_AGENT); }
__device__ __forceinline__ unsigned xb_xcc_id() { return (unsigned)__builtin_amdgcn_s_getreg((3 << 11) | 20) & 0xFu; }
#define XB_SPIN(cond, bar) do { unsigned _sp = 0; while (cond) { __builtin_amdgcn_s_sleep(1); \
    if ((++_sp & 255u) == 0u) { if (xb_ld(&(bar)[XB_TMO])) break; if (_sp > XB_SPIN_CAP) { atomicAdd(&(bar)[XB_TMO], 1u); break; } } } } while (0)
struct XcdBarrier { unsigned* bar; unsigned x; volatile LAS unsigned* st; };
__device__ __forceinline__ XcdBarrier xcd_barrier_post(unsigned* bar, volatile LAS unsigned* st) {
    XcdBarrier b; b.bar = bar; b.x = xb_xcc_id(); b.st = st;
    if (threadIdx.x == 0) (void)xb_add(&bar[XB_XCNT(b.x)], 1u);
    return b;
}
__device__ __forceinline__ void xcd_barrier_complete(unsigned* bar, unsigned x, unsigned& nloc, unsigned& nx) {
    const unsigned G = gridDim.x * gridDim.y * gridDim.z;
    unsigned sum, cnt, mine, sp = 0u;
    for (;;) {
        sum = 0u; cnt = 0u; mine = 0u;
#pragma unroll
        for (unsigned j = 0; j < 16; ++j) { const unsigned c = xb_ld(&bar[XB_XCNT(j)]); sum += c; cnt += (c > 0u) ? 1u : 0u; mine = (j == x) ? c : mine; }
        if (sum == G) break;
        __builtin_amdgcn_s_sleep(1);
        if ((++sp & 255u) == 0u) { if (xb_ld(&bar[XB_TMO])) break; if (sp > XB_SPIN_CAP) { atomicAdd(&bar[XB_TMO], 1u); break; } }
    }
    nloc = mine > 0u ? mine : 1u; nx = cnt > 0u ? cnt : 1u;
}
__device__ __forceinline__ void xcd_barrier(const XcdBarrier& b) {
    asm volatile("s_waitcnt vmcnt(0)" ::: "memory");
    __syncthreads();
    if (threadIdx.x == 0) {
        unsigned* bar = b.bar;
        __builtin_amdgcn_s_waitcnt(0);
        unsigned nloc = b.st[0], nx = b.st[1];
        if (nloc == 0u) { xcd_barrier_complete(bar, b.x, nloc, nx); b.st[0] = nloc; b.st[1] = nx; }
        const unsigned old = xb_add(&bar[XB_XSUB(b.x)], 1u);
        const unsigned gen = old / nloc;
        if (old + 1u == (gen + 1u) * nloc) {
            __builtin_amdgcn_fence(__ATOMIC_RELEASE, "agent");
            asm volatile("s_waitcnt vmcnt(0)" ::: "memory");
            const unsigned og = xb_add(&bar[XB_TOP], 1u);
            const unsigned tg = og / nx;
            if (og + 1u == (tg + 1u) * nx) xb_add(&bar[XB_TOPGEN], 1u);
            else XB_SPIN(xb_ld(&bar[XB_TOPGEN]) == tg, bar);
            __builtin_amdgcn_fence(__ATOMIC_ACQUIRE, "agent");
            xb_add(&bar[XB_XGEN(b.x)], 1u);
            asm volatile("s_waitcnt vmcnt(0)" ::: "memory");
        } else {
            XB_SPIN(xb_ld(&bar[XB_XGEN(b.x)]) == gen, bar);
            __builtin_amdgcn_fence(__ATOMIC_ACQUIRE, "agent");
            asm volatile("s_waitcnt vmcnt(0)" ::: "memory");
        }
    }
    __syncthreads();
}
#define GRID_SYNC() xcd_barrier(xbar)
#define GRID_SYNC_CG() do { asm volatile("s_waitcnt vmcnt(0) lgkmcnt(0)" ::: "memory"); __builtin_amdgcn_fence(__ATOMIC_RELEASE, "agent"); asm volatile("s_waitcnt vmcnt(0)" ::: "memory"); \
    grid.sync(); __builtin_amdgcn_fence(__ATOMIC_ACQUIRE, "agent"); asm volatile("s_waitcnt vmcnt(0)" ::: "memory"); __syncthreads(); } while (0)
__global__ void __launch_bounds__(512, 2) hymba_fwd(Params p) {
    extern __shared__ __attribute__((aligned(16))) unsigned char lds_raw[];
    LAS unsigned char* lds = (LAS unsigned char*)lds_raw;
    cg::grid_group grid = cg::this_grid();
    unsigned char* ws = p.ws;
    const int G = gridDim.x;
    if (threadIdx.x < 2) ((volatile LAS unsigned*)(lds + 131072 + 64))[threadIdx.x] = 0u;
    __syncthreads();
    if (blockIdx.x == 0) for (int i = threadIdx.x; i < 32768 / 16; i += 512) ((u32x4*)ws)[i] = (u32x4){0u, 0u, 0u, 0u};

    phase0(p, lds);
    GRID_SYNC_CG();
    const XcdBarrier xbar = xcd_barrier_post((unsigned*)(ws + 4096), (volatile LAS unsigned*)(lds + 131072 + 64));
    phase1a(p, lds);
    GRID_SYNC();
    {
        pg8::Gemm g{(const bf16_t*)(ws + WS_H), (const bf16_t*)(ws + WS_WTIN), T_, NU, DM}; pg8::StaticOrder S; S.init(T_, NU, G, (int)blockIdx.x);
        pg8::EpiU E{(bf16_t*)(ws + WS_U), NU};
        pg8::gemm_phase<pg8::EpiU, pg8::StaticOrder, true>(lds, g, S, E);
    }
    GRID_SYNC();
    phase2a(p, lds);
    GRID_SYNC();
    mlstm_a_phase(p, lds, (int)blockIdx.x, G);
    GRID_SYNC();
    {
        float THR;
        { const int lane = threadIdx.x & 63; float a = fabsf(p.gq[lane]), b = fabsf(p.gk[lane]);
#pragma unroll
          for (int o = 1; o < 64; o <<= 1) { a = fmaxf(a, __shfl_xor(a, o)); b = fmaxf(b, __shfl_xor(b, o)); }
          THR = 16.f * a * b + 16.f; }
        unsigned* qctr = (unsigned*)ws + 16; unsigned* sdone = (unsigned*)ws + 32;
        LAS int* qslot = (LAS int*)(lds + 131072);
        if (threadIdx.x < 64) *(LAS float*)(lds + 131072 + 256 + threadIdx.x * 4) = p.gq[threadIdx.x];
        *(LAS float*)(lds + 131072 + 512 + threadIdx.x * 4) = p.mnorm_g[threadIdx.x];
        for (;;) {
            if (threadIdx.x == 0) *qslot = (int)__hip_atomic_fetch_add(qctr, 1u, __ATOMIC_RELAXED, __HIP_MEMORY_SCOPE_AGENT);
            __syncthreads();
            const int it = *qslot;
            __syncthreads();
            constexpr int C_BASE = SCAN_ITEMS + 1024;
            if (it >= C_BASE) {
                if (it < C_BASE + 2048) {
                    if (threadIdx.x == 0) { while (__hip_atomic_load(sdone, __ATOMIC_RELAXED, __HIP_MEMORY_SCOPE_AGENT) < (unsigned)SCAN_ITEMS) __builtin_amdgcn_s_sleep(2);
                        __builtin_amdgcn_fence(__ATOMIC_ACQUIRE, "agent"); asm volatile("s_waitcnt vmcnt(0)" ::: "memory"); }
                    __syncthreads();
                    mlstm_c_phase(p, lds, it - C_BASE, qctr, qslot, C_BASE);
                }
                break;
            }
            if (it >= 128 && it < 128 + SCAN_ITEMS) {
                mlstm_scan(p, it - 128);
                asm volatile("s_waitcnt vmcnt(0)" ::: "memory");
                __syncthreads();
                if (threadIdx.x == 0) { __builtin_amdgcn_fence(__ATOMIC_RELEASE, "agent"); asm volatile("s_waitcnt vmcnt(0)" ::: "memory"); (void)__hip_atomic_fetch_add(sdone, 1u, __ATOMIC_RELAXED, __HIP_MEMORY_SCOPE_AGENT); }
            }
            else { const int f = (it < 128) ? it : it - SCAN_ITEMS; const int h = 7 - (f >> 7), r = f & 127, b = r & 3, qb = 31 - (r >> 2); fox_unit(p, lds, b * 8 + h, qb, THR); }
        }
    }
    GRID_SYNC();
    {
        pg8::Gemm g{(const bf16_t*)(ws + WS_Y), (const bf16_t*)(ws + WS_WTOUT), T_, DM, DM}; pg8::StaticOrder S; S.init(T_, DM, G, (int)blockIdx.x);
        pg8::EpiOut E{p.x, (const float*)(ws + WS_MOD), p.out};
        pg8::gemm_phase<pg8::EpiOut, pg8::StaticOrder, true>(lds, g, S, E);
    }
}

extern "C" void kernel_launch(void* const* d_in, const int* in_sizes, int n_in, void* d_out, int out_size, void* d_ws, size_t ws_size, hipStream_t stream) {
    static int grid = 0;
    if (grid == 0) {
        if (n_in != 15 || in_sizes[0] != T_ * DM || out_size != T_ * DM || ws_size < WS_END) { fprintf(stderr, "kernel_launch: unexpected shapes (n_in %d, in0 %d, out %d, ws %zu)\n", n_in, n_in > 0 ? in_sizes[0] : -1, out_size, ws_size); grid = -1; return; }
        int dev = 0, cus = 0, per_cu = 0;
        hipGetDevice(&dev);
        hipDeviceGetAttribute(&cus, hipDeviceAttributeMultiprocessorCount, dev);
        if (hipFuncSetAttribute((const void*)hymba_fwd, hipFuncAttributeMaxDynamicSharedMemorySize, LDS_BYTES) != hipSuccess) { fprintf(stderr, "kernel_launch: hipFuncSetAttribute failed\n"); grid = -1; return; }
        hipOccupancyMaxActiveBlocksPerMultiprocessor(&per_cu, (const void*)hymba_fwd, 512, LDS_BYTES);
        if (per_cu < 1) { fprintf(stderr, "kernel_launch: occupancy query says %d blocks per CU\n", per_cu); per_cu = 1; }
        (void)hipGetLastError();
        grid = cus * 1;
    }
    if (grid < 0) return;
    Params p{};
    p.x = (const float*)d_in[0]; p.c = (const float*)d_in[1]; p.norm_g = (const float*)d_in[2]; p.w_ada = (const float*)d_in[3]; p.b_ada = (const float*)d_in[4];
    p.w_in = (const float*)d_in[5]; p.conv_w = (const float*)d_in[6]; p.conv_b = (const float*)d_in[7]; p.b_ig = (const float*)d_in[8]; p.b_fm = (const float*)d_in[9];
    p.mnorm_g = (const float*)d_in[10]; p.b_ff = (const float*)d_in[11]; p.gq = (const float*)d_in[12]; p.gk = (const float*)d_in[13]; p.w_out = (const float*)d_in[14];
    p.out = (float*)d_out; p.ws = (unsigned char*)d_ws;
    void* args[] = {&p};
    hipError_t e = hipLaunchCooperativeKernel((const void*)hymba_fwd, dim3(grid), dim3(512), args, LDS_BYTES, stream);
    if (e != hipSuccess) fprintf(stderr, "cooperative launch failed: %s (grid %d)\n", hipGetErrorString(e), grid);
}
```
